# Optimizing an MI355X kernel written in HIP

```python
import math
import jax, jax.numpy as jnp
from jax import lax
import numpy as np

D_MODEL = 1024
BATCH = 8
SEQ = 4096
DEPTH = 1

GRID_W = 64
CTX_LEN = 256
D_MIX = D_MODEL
D_RET = D_MIX // 2
D_HYENA = D_MIX - D_RET
RET_HEADS = 4
RET_HEAD_DIM = D_RET // RET_HEADS
RET_CHUNK = 128
ROPE_BASE = 10000.0
HYENA_PROJ = 3
HYENA_SHORT = 3
FILTER_EMB = 33
FILTER_HIDDEN = 64
FILTER_DECAY_FAST = 0.3
FILTER_DECAY_SLOW = 1.5
FILTER_DECAY_TARGET = 1e-2
D_IN = 4 * D_RET + HYENA_PROJ * D_HYENA
D_FF = ((-(-8 * D_MODEL // 3)) + 255) // 256 * 256
N_MOD = 6
EPS = 1e-6

kernel_name = "hybrid_retention_hyena_dit_block"

F32 = jnp.float32


def rms_norm(x, gain):
    xf = x.astype(F32)
    y = xf * lax.rsqrt(jnp.mean(xf * xf, axis=-1, keepdims=True) + EPS)
    return (y * gain.astype(F32)).astype(x.dtype)


def modulate(h, shift, scale):
    return h * (1 + scale) + shift


def to_heads(t):
    b, l, _ = t.shape
    return t.reshape(b, l, RET_HEADS, RET_HEAD_DIM).transpose(0, 2, 1, 3)


def flip_seq(t):
    return jnp.flip(t, axis=2)


def rope_tables(rows, cols):
    n = RET_HEAD_DIM // 4
    inv = ROPE_BASE ** (-jnp.arange(n, dtype=F32) / n)
    ang = jnp.concatenate([rows[:, None] * inv, cols[:, None] * inv], axis=-1)
    return jnp.cos(ang), jnp.sin(ang)


def apply_rope(t, cos, sin):
    half = RET_HEAD_DIM // 2
    t = t.astype(F32)
    t1, t2 = t[..., :half], t[..., half:]
    return jnp.concatenate([t1 * cos - t2 * sin, t1 * sin + t2 * cos], axis=-1)


def log_gamma_from(ret_decay):
    return jnp.log1p(-jnp.exp(ret_decay.astype(F32)))


def retention_chunked(q, k, v, log_gamma, s0):
    q, k, v = q.astype(F32), k.astype(F32), v.astype(F32)
    b, h, n, dh = q.shape
    nc = n // RET_CHUNK
    qc = q.reshape(b, h, nc, RET_CHUNK, dh)
    kc = k.reshape(b, h, nc, RET_CHUNK, dh)
    vc = v.reshape(b, h, nc, RET_CHUNK, dh)
    idx = jnp.arange(RET_CHUNK, dtype=F32)
    diff = idx[:, None] - idx[None, :]
    dmask = jnp.where(diff >= 0, jnp.exp(log_gamma[:, None, None] * jnp.maximum(diff, 0.0)), 0.0)
    scores = jnp.einsum('bhnid,bhnjd->bhnij', qc, kc) * dmask[None, :, None]
    inner = jnp.einsum('bhnij,bhnje->bhnie', scores, vc)
    k_w = jnp.exp(log_gamma[:, None] * (RET_CHUNK - 1 - idx))
    kv = jnp.einsum('bhnjd,bhnje,hj->nbhde', kc, vc, k_w)
    chunk_decay = jnp.exp(log_gamma * RET_CHUNK)[None, :, None, None]

    def step(s, kv_n):
        return s * chunk_decay + kv_n, s

    s_final, s_prev = lax.scan(step, s0.astype(F32), kv)
    q_w = jnp.exp(log_gamma[:, None] * (idx + 1))
    cross = jnp.einsum('bhnid,nbhde,hi->bhnie', qc, s_prev, q_w)
    return (inner + cross).reshape(b, h, n, dh), s_final


def retention_state(k, v, log_gamma):
    n = k.shape[2]
    w = jnp.exp(log_gamma[:, None] * (n - 1 - jnp.arange(n, dtype=F32)))
    return jnp.einsum('bhnd,bhne,hn->bhde', k.astype(F32), v.astype(F32), w)


def retention_out(o_fwd, o_bwd, g, gn_gain):
    o = o_fwd + o_bwd
    mu = jnp.mean(o, axis=-1, keepdims=True)
    var = jnp.mean(jnp.square(o - mu), axis=-1, keepdims=True)
    o = (o - mu) * lax.rsqrt(var + EPS)
    b, h, l, dh = o.shape
    o = o.transpose(0, 2, 1, 3).reshape(b, l, h * dh)
    return (o * gn_gain.astype(F32) * jax.nn.silu(g.astype(F32))).astype(g.dtype)


def short_conv(u, w, bias):
    pad = HYENA_SHORT // 2
    y = lax.conv_general_dilated(u, w.astype(u.dtype)[:, None, :], window_strides=(1,),
                                 padding=((pad, pad),), dimension_numbers=('NWC', 'WIO', 'NWC'),
                                 feature_group_count=u.shape[-1])
    return y + bias.astype(u.dtype)


def hyena_filter(seq_len, w1, b1, w2, b2, w3, b3, w4, freq):
    t = jnp.linspace(0.0, 1.0, seq_len, dtype=F32)[:, None]
    bands = (FILTER_EMB - 1) // 2
    f = jnp.linspace(1e-4, bands - 1, bands, dtype=F32)[None, :]
    wpos = 2.0 * math.pi * jnp.arange(seq_len, dtype=F32)[:, None] / seq_len
    emb = jnp.concatenate([t, jnp.cos(f * wpos), -jnp.sin(f * wpos)], axis=-1)
    fr = freq.astype(F32)
    h = jnp.sin(fr * (emb @ w1.astype(F32) + b1.astype(F32)))
    h = jnp.sin(fr * (h @ w2.astype(F32) + b2.astype(F32)))
    h = jnp.sin(fr * (h @ w3.astype(F32) + b3.astype(F32)))
    h = (h @ w4.astype(F32)).reshape(seq_len, 2, D_HYENA)
    max_decay = math.log(FILTER_DECAY_TARGET) / FILTER_DECAY_FAST
    min_decay = math.log(FILTER_DECAY_TARGET) / FILTER_DECAY_SLOW
    deltas = jnp.linspace(min_decay, max_decay, D_HYENA, dtype=F32)
    window = jnp.exp(-t * jnp.abs(deltas)[None, :])
    h = h * window[:, None, :]
    h_fwd, h_bwd = h[:, 0], h[:, 1]
    kern = jnp.concatenate([h_fwd, jnp.zeros((1, D_HYENA), F32), jnp.flip(h_bwd[1:], axis=0)], axis=0)
    kern = kern / (jnp.sum(jnp.abs(kern), axis=0, keepdims=True) + EPS)
    return jnp.fft.rfft(kern, axis=0)


def fft_long_conv(u, kern_f, bias):
    seq_len = u.shape[1]
    u_f = jnp.fft.rfft(u, n=2 * seq_len, axis=1)
    y = jnp.fft.irfft(u_f * kern_f[None], n=2 * seq_len, axis=1)[:, :seq_len]
    return y + u * bias.astype(F32)


def hyena_mix(hy, short_w, short_b, w1, b1, w2, b2, w3, b3, w4, freq, bias, out_gain):
    seq_len = hy.shape[1]
    u = short_conv(hy.astype(F32), short_w, short_b)
    x0, x1, v = u[..., :D_HYENA], u[..., D_HYENA:2 * D_HYENA], u[..., 2 * D_HYENA:]
    kern_f = hyena_filter(seq_len, w1, b1, w2, b2, w3, b3, w4, freq)
    y = x0 * fft_long_conv(v * x1, kern_f, bias)
    return rms_norm(y, out_gain).astype(hy.dtype)


def swiglu(h, w_gate_up, w_down):
    gu = h @ w_gate_up
    return (jax.nn.silu(gu[..., :D_FF]) * gu[..., D_FF:]) @ w_down


def setup_inputs(seed: int = 0) -> dict:
    key = jax.random.key(seed)
    ks = jax.random.split(key, 28)
    nrm = lambda k, shape, s: jax.random.normal(k, shape, F32) * s
    ln2 = math.log(2.0)
    decay_init = -(5.0 + jnp.arange(RET_HEADS, dtype=F32)) * ln2
    return {
        "x": nrm(ks[0], (BATCH, SEQ, D_MODEL), 1.0),
        "c": nrm(ks[1], (BATCH, D_MODEL), 1.0),
        "ctx": nrm(ks[2], (BATCH, CTX_LEN, D_MODEL), 1.0),
        "c_ctx": nrm(ks[3], (D_MODEL,), 1.0),
        "w_mod": nrm(ks[4], (DEPTH, D_MODEL, N_MOD * D_MODEL), 0.5 * D_MODEL ** -0.5),
        "b_mod": nrm(ks[5], (DEPTH, N_MOD * D_MODEL), 0.02),
        "norm1": 1.0 + nrm(ks[6], (DEPTH, D_MODEL), 0.02),
        "norm2": 1.0 + nrm(ks[7], (DEPTH, D_MODEL), 0.02),
        "w_in": nrm(ks[8], (DEPTH, D_MODEL, D_IN), D_MODEL ** -0.5),
        "ret_decay": decay_init[None, None, :] + nrm(ks[9], (DEPTH, 2, RET_HEADS), 0.05),
        "ret_gn_gain": 1.0 + nrm(ks[10], (DEPTH, D_RET), 0.02),
        "hy_short_w": nrm(ks[11], (DEPTH, HYENA_SHORT, HYENA_PROJ * D_HYENA), HYENA_SHORT ** -0.5),
        "hy_short_b": nrm(ks[12], (DEPTH, HYENA_PROJ * D_HYENA), 0.02),
        "hy_w1": nrm(ks[13], (DEPTH, FILTER_EMB, FILTER_HIDDEN), FILTER_EMB ** -0.5),
        "hy_b1": nrm(ks[14], (DEPTH, FILTER_HIDDEN), 0.1),
        "hy_w2": nrm(ks[15], (DEPTH, FILTER_HIDDEN, FILTER_HIDDEN), FILTER_HIDDEN ** -0.5),
        "hy_b2": nrm(ks[16], (DEPTH, FILTER_HIDDEN), 0.1),
        "hy_w3": nrm(ks[17], (DEPTH, FILTER_HIDDEN, FILTER_HIDDEN), FILTER_HIDDEN ** -0.5),
        "hy_b3": nrm(ks[18], (DEPTH, FILTER_HIDDEN), 0.1),
        "hy_w4": nrm(ks[19], (DEPTH, FILTER_HIDDEN, 2 * D_HYENA), FILTER_HIDDEN ** -0.5),
        "hy_freq": 1.0 + nrm(ks[20], (DEPTH, FILTER_HIDDEN), 0.02),
        "hy_bias": nrm(ks[21], (DEPTH, D_HYENA), 1.0),
        "hy_out_norm": 1.0 + nrm(ks[22], (DEPTH, D_HYENA), 0.02),
        "w_out": nrm(ks[23], (DEPTH, D_MIX, D_MODEL), D_MIX ** -0.5),
        "w_gate_up": nrm(ks[24], (DEPTH, D_MODEL, 2 * D_FF), D_MODEL ** -0.5),
        "w_down": nrm(ks[25], (DEPTH, D_FF, D_MODEL), D_FF ** -0.5),
        "final_norm": 1.0 + nrm(ks[26], (D_MODEL,), 0.02),
    }


def reference(x, c, ctx, c_ctx, w_mod, b_mod, norm1, norm2, w_in, ret_decay, ret_gn_gain,
              hy_short_w, hy_short_b, hy_w1, hy_b1, hy_w2, hy_b2, hy_w3, hy_b3, hy_w4,
              hy_freq, hy_bias, hy_out_norm, w_out, w_gate_up, w_down, final_norm):
    b, seq_len, _ = x.shape
    rows_n = seq_len // GRID_W
    rows = jnp.repeat(jnp.arange(rows_n, dtype=F32), GRID_W)
    cols = jnp.tile(jnp.arange(GRID_W, dtype=F32), rows_n)
    cos, sin = rope_tables(rows, cols)
    k_scale = RET_HEAD_DIM ** -0.5

    for layer in range(DEPTH):
        last = layer == DEPTH - 1
        mod = (jax.nn.silu(c) @ w_mod[layer] + b_mod[layer]).reshape(b, N_MOD, 1, D_MODEL)
        mod_c = (jax.nn.silu(c_ctx) @ w_mod[layer] + b_mod[layer]).reshape(N_MOD, D_MODEL)
        lg = log_gamma_from(ret_decay[layer])
        hy_p = (hy_short_w[layer], hy_short_b[layer], hy_w1[layer], hy_b1[layer], hy_w2[layer],
                hy_b2[layer], hy_w3[layer], hy_b3[layer], hy_w4[layer], hy_freq[layer],
                hy_bias[layer], hy_out_norm[layer])

        hc = modulate(rms_norm(ctx, norm1[layer]), mod_c[0], mod_c[1])
        if last:
            kvc = hc @ w_in[layer][:, D_RET:3 * D_RET]
            kc = to_heads(kvc[..., :D_RET]) * k_scale
            vc = to_heads(kvc[..., D_RET:])
            s_fwd = retention_state(kc, vc, lg[0])
            s_bwd = retention_state(flip_seq(kc), flip_seq(vc), lg[1])
        else:
            pc = hc @ w_in[layer]
            qc = to_heads(pc[..., :D_RET])
            kc = to_heads(pc[..., D_RET:2 * D_RET]) * k_scale
            vc = to_heads(pc[..., 2 * D_RET:3 * D_RET])
            zero = jnp.zeros((b, RET_HEADS, RET_HEAD_DIM, RET_HEAD_DIM), F32)
            oc_f, s_fwd = retention_chunked(qc, kc, vc, lg[0], zero)
            oc_b, s_bwd = retention_chunked(flip_seq(qc), flip_seq(kc), flip_seq(vc), lg[1], zero)
            ret_c = retention_out(oc_f, flip_seq(oc_b), pc[..., 3 * D_RET:4 * D_RET], ret_gn_gain[layer])
            hy_c = hyena_mix(pc[..., 4 * D_RET:], *hy_p)
            ctx_mix = jnp.concatenate([ret_c, hy_c], axis=-1) @ w_out[layer]

        h = modulate(rms_norm(x, norm1[layer]), mod[:, 0], mod[:, 1])
        p = h @ w_in[layer]
        q = apply_rope(to_heads(p[..., :D_RET]), cos, sin)
        k = apply_rope(to_heads(p[..., D_RET:2 * D_RET]), cos, sin) * k_scale
        v = to_heads(p[..., 2 * D_RET:3 * D_RET])
        o_f, _ = retention_chunked(q, k, v, lg[0], s_fwd)
        o_b, _ = retention_chunked(flip_seq(q), flip_seq(k), flip_seq(v), lg[1], s_bwd)
        ret_x = retention_out(o_f, flip_seq(o_b), p[..., 3 * D_RET:4 * D_RET], ret_gn_gain[layer])
        hy_x = hyena_mix(p[..., 4 * D_RET:], *hy_p)
        mix = jnp.concatenate([ret_x, hy_x], axis=-1) @ w_out[layer]
        x = x + (mod[:, 2] * mix).astype(x.dtype)

        h2 = modulate(rms_norm(x, norm2[layer]), mod[:, 3], mod[:, 4])
        x = x + (mod[:, 5] * swiglu(h2, w_gate_up[layer], w_down[layer])).astype(x.dtype)

        if not last:
            ctx = ctx + (mod_c[2] * ctx_mix).astype(ctx.dtype)
            hc2 = modulate(rms_norm(ctx, norm2[layer]), mod_c[3], mod_c[4])
            ctx = ctx + (mod_c[5] * swiglu(hc2, w_gate_up[layer], w_down[layer])).astype(ctx.dtype)

    return rms_norm(x, final_norm)
```

```cpp
#define MULTI_LAUNCH 1
#include <hip/hip_runtime.h>
#include <hip/hip_cooperative_groups.h>
#include <cstdio>
namespace cg = cooperative_groups;

#define DI __device__ __forceinline__
#define LAS __attribute__((address_space(3)))
#define PG8_LAS __attribute__((address_space(3)))
typedef unsigned short bf16_t;
typedef short bf16x8 __attribute__((ext_vector_type(8)));
typedef short s16x4 __attribute__((ext_vector_type(4)));
typedef float f32x4 __attribute__((ext_vector_type(4)));
typedef float f32x16 __attribute__((ext_vector_type(16)));
typedef unsigned u32x4 __attribute__((ext_vector_type(4)));
typedef unsigned u32x2 __attribute__((ext_vector_type(2)));

constexpr int NB = 8, SEQ = 4096, DM = 1024, MTOK = NB * SEQ, CTXL = 256, MCTX = NB * CTXL;
constexpr int DIN = 3584, DFF = 2816, NH = 4, DHD = 128, NMOD = 6;
constexpr float EPSF = 1e-6f;
constexpr int NTHR = 512;
constexpr int LDS_BYTES = 160 * 1024;

constexpr size_t WS_WIN = 0;
constexpr size_t WS_WOUT = WS_WIN + (size_t)DIN * DM * 2;
constexpr size_t WS_WGU = WS_WOUT + (size_t)DM * DM * 2;
constexpr size_t WS_WDN = WS_WGU + (size_t)2 * DFF * DM * 2;
constexpr size_t WS_MOD = WS_WDN + (size_t)DM * DFF * 2;
constexpr size_t WS_ROPE = WS_MOD + (size_t)9 * 6144 * 4;
constexpr size_t WS_FH3 = WS_ROPE + (size_t)SEQ * 64 * 2 * 4;
constexpr size_t WS_KERN = WS_FH3 + (size_t)SEQ * 64 * 4;
constexpr size_t WS_KSUM = WS_KERN + (size_t)2 * 512 * SEQ * 4;
constexpr size_t WS_MISC = WS_KSUM + 2048;
constexpr size_t WS_KVC = WS_MISC + 4096 + 2048;
constexpr size_t WS_HA = WS_KVC + (size_t)MCTX * 1024 * 2;
constexpr size_t WS_P = WS_HA + (size_t)(MTOK + MCTX) * DM * 2;
constexpr size_t WS_ST = WS_P + (size_t)MTOK * DIN * 2;
constexpr size_t WS_U = WS_ST + (size_t)2 * 32 * 32 * 16384 * 2;
constexpr size_t WS_YC = WS_U + (size_t)512 * NB * SEQ * 2;
constexpr size_t WS_END = WS_YC + (size_t)512 * NB * SEQ * 2;
constexpr size_t WS_MIXIN = WS_HA, WS_H2 = WS_HA, WS_ACT = WS_P;

struct Params { const float* in[27]; float* out; unsigned char* ws; };

DI unsigned short f2bf(float f) { unsigned u = __float_as_uint(f); u += 0x7FFFu + ((u >> 16) & 1u); return (unsigned short)(u >> 16); }
DI float bf2f(unsigned short b) { return __uint_as_float(((unsigned)b) << 16); }
DI unsigned pk2(float lo, float hi) { return (unsigned)f2bf(lo) | ((unsigned)f2bf(hi) << 16); }
DI float bflo(unsigned w) { return __uint_as_float(w << 16); }
DI float bfhi(unsigned w) { return __uint_as_float(w & 0xffff0000u); }
DI float wave_sum(float v) {
#pragma unroll
    for (int o = 32; o > 0; o >>= 1) v += __shfl_xor(v, o);
    return v;
}
DI float sigmoidf_(float x) { return 1.0f / (1.0f + __expf(-x)); }
#define MFMA16(a, b, c) __builtin_amdgcn_mfma_f32_16x16x32_bf16((a), (b), (c), 0, 0, 0)
#define MFMA32(a, b, c) __builtin_amdgcn_mfma_f32_32x32x16_bf16((a), (b), (c), 0, 0, 0)

DI bf16x8 tr_read8(const LAS unsigned char* p, int hi_off) {
    const s16x4 lo = __builtin_amdgcn_ds_read_tr16_b64_v4i16((LAS s16x4*)p);
    const s16x4 hi = __builtin_amdgcn_ds_read_tr16_b64_v4i16((LAS s16x4*)(p + hi_off));
    return __builtin_shufflevector(lo, hi, 0, 1, 2, 3, 4, 5, 6, 7);
}
namespace pg8 {
constexpr int BM = 256, BK = 64, HALF = 128, HTB = HALF * BK * 2  , STAGE_BYTES = 8 * HTB, NXCD = 8, WGM = 8;

__host__ __device__ __forceinline__ int lds_byte(int r, int c) { const int st = (r >> 4) * 2 + (c >> 5), rr = r & 15, cc = c & 31, ob = rr * 64 + cc * 2; return st * 1024 + (ob ^ (((ob >> 9) & 1) << 5)); }
__host__ __device__ __forceinline__ void stage_rc(int b, int& R, int& C) { const int st = b / 1024, sb = b % 1024, swz = sb ^ (((sb >> 9) & 1) << 5); R = (st >> 1) * 16 + swz / 64; C = (st & 1) * 32 + (swz % 64) / 2; }
__host__ __device__ __forceinline__ int perm32(int rho) { const int n = rho >> 4, i = rho & 15; return 8 * (i >> 2) + 4 * n + (i & 3); }

struct Unit { int pm, pn; };
struct Gemm { const bf16_t* A; const bf16_t* Bt; int M, N, K; };

struct StaticOrder {
    int nM, nN, nwg, G, c;
    __host__ __device__ void init(int M, int N, int G_, int c_) { nM = M / BM; nN = N / BM; nwg = nM * nN; G = G_; c = c_; }
    __host__ __device__ bool next(int i, Unit& u) const {
        const long L = (long)i * G + c; if (L >= nwg) return false;
        int wgid = (int)L; { const int q = nwg / NXCD, r = nwg % NXCD, xcd = wgid % NXCD, off = wgid / NXCD; wgid = (xcd < r ? xcd * (q + 1) : r * (q + 1) + (xcd - r) * q) + off; }
        const int nig = WGM * nN, gid = wgid / nig, fm = gid * WGM, gsz = (nM - fm) < WGM ? (nM - fm) : WGM;
        u.pm = fm + ((wgid % nig) % gsz); u.pn = (wgid % nig) / gsz; return true;
    }
    __device__ __forceinline__ void a_ready(const Unit&) const {}
    __device__ __forceinline__ void done(const Unit&) const {}
};

struct EpiP {
    static constexpr bool PERM = true, AFTER_DRAIN = false;
    bf16_t* P; const float* rope;
    __device__ __forceinline__ void operator()(const f32x4 (&acc)[2][2][4][2], const Unit& u, int wr, int wc, int fr, int fq) const {
        const int row0 = u.pm * BM + wr * 64 + fr, col0 = u.pn * BM + wc * 32 + 8 * fq;
        const int mode = u.pn < 2 ? 1 : (u.pn < 4 ? 2 : 0);
        const float sc = mode == 2 ? 0.08838834764831845f : 1.0f;
        const int mp = 16 * wc + 4 * fq;
#pragma unroll
        for (int ai = 0; ai < 2; ++ai)
#pragma unroll
            for (int m = 0; m < 4; ++m) {
                const int row = row0 + ai * HALF + m * 16;
                bf16_t* rowp = P + (size_t)row * DIN + col0;
                f32x4 r0 = {1.f, 0.f, 1.f, 0.f}, r1 = {1.f, 0.f, 1.f, 0.f};
                if (mode) { const float* rp = rope + ((size_t)(row & (SEQ - 1)) * 64 + mp) * 2; r0 = *(const f32x4*)rp; r1 = *(const f32x4*)(rp + 4); }
#pragma unroll
                for (int bj = 0; bj < 2; ++bj) {
                    f32x4 v0 = acc[ai][bj][m][0], v1 = acc[ai][bj][m][1];
                    if (mode) {
                        f32x4 a, b;
                        a[0] = v0[0] * r0[0] - v0[1] * r0[1]; a[1] = v0[0] * r0[1] + v0[1] * r0[0];
                        a[2] = v0[2] * r0[2] - v0[3] * r0[3]; a[3] = v0[2] * r0[3] + v0[3] * r0[2];
                        b[0] = v1[0] * r1[0] - v1[1] * r1[1]; b[1] = v1[0] * r1[1] + v1[1] * r1[0];
                        b[2] = v1[2] * r1[2] - v1[3] * r1[3]; b[3] = v1[2] * r1[3] + v1[3] * r1[2];
                        v0 = a * sc; v1 = b * sc;
                    }
                    u32x4 w; w.x = pk2(v0[0], v0[1]); w.y = pk2(v0[2], v0[3]); w.z = pk2(v1[0], v1[1]); w.w = pk2(v1[2], v1[3]);
                    *(u32x4*)(rowp + bj * HALF) = w;
                }
            }
    }
};
struct EpiKV {
    static constexpr bool PERM = true, AFTER_DRAIN = false;
    bf16_t* O;
    __device__ __forceinline__ void operator()(const f32x4 (&acc)[2][2][4][2], const Unit& u, int wr, int wc, int fr, int fq) const {
        const int row0 = u.pm * BM + wr * 64 + fr, col0 = u.pn * BM + wc * 32 + 8 * fq;
        const float sc = u.pn < 2 ? 0.08838834764831845f : 1.0f;
#pragma unroll
        for (int ai = 0; ai < 2; ++ai)
#pragma unroll
            for (int m = 0; m < 4; ++m) {
                bf16_t* rowp = O + (size_t)(row0 + ai * HALF + m * 16) * 1024 + col0;
#pragma unroll
                for (int bj = 0; bj < 2; ++bj) {
                    const f32x4 v0 = acc[ai][bj][m][0] * sc, v1 = acc[ai][bj][m][1] * sc;
                    u32x4 w; w.x = pk2(v0[0], v0[1]); w.y = pk2(v0[2], v0[3]); w.z = pk2(v1[0], v1[1]); w.w = pk2(v1[2], v1[3]);
                    *(u32x4*)(rowp + bj * HALF) = w;
                }
            }
    }
};
struct EpiRes {
    static constexpr bool PERM = false, AFTER_DRAIN = false;
    const float* resid; float* out; const float* gate;
    __device__ __forceinline__ void operator()(const f32x4 (&acc)[2][2][4][2], const Unit& u, int wr, int wc, int fr, int fq) const {
        const int row0 = u.pm * BM + wr * 64 + fr, col0 = u.pn * BM + wc * 32 + 4 * fq;
        const int b = (u.pm * BM) >> 12;
        f32x4 gv[2][2];
#pragma unroll
        for (int bj = 0; bj < 2; ++bj)
#pragma unroll
            for (int n = 0; n < 2; ++n) gv[bj][n] = *(const f32x4*)(gate + (size_t)b * 6144 + col0 + bj * HALF + n * 16);
#pragma unroll
        for (int ai = 0; ai < 2; ++ai)
#pragma unroll
            for (int m = 0; m < 4; ++m) {
                const size_t off = (size_t)(row0 + ai * HALF + m * 16) * DM + col0;
#pragma unroll
                for (int bj = 0; bj < 2; ++bj)
#pragma unroll
                    for (int n = 0; n < 2; ++n) { const f32x4 r = *(const f32x4*)(resid + off + bj * HALF + n * 16); *(f32x4*)(out + off + bj * HALF + n * 16) = r + gv[bj][n] * acc[ai][bj][m][n]; }
            }
    }
};
struct EpiSwiGLU {
    static constexpr bool PERM = true, AFTER_DRAIN = false;
    bf16_t* O;
    __device__ __forceinline__ void operator()(const f32x4 (&acc)[2][2][4][2], const Unit& u, int wr, int wc, int fr, int fq) const {
        const int row0 = u.pm * BM + wr * 64 + fr, col0 = u.pn * HALF + wc * 32 + 8 * fq;
#pragma unroll
        for (int ai = 0; ai < 2; ++ai)
#pragma unroll
            for (int m = 0; m < 4; ++m) {
                bf16_t* rowp = O + (size_t)(row0 + ai * HALF + m * 16) * DFF + col0;
                f32x4 v0, v1;
#pragma unroll
                for (int j = 0; j < 4; ++j) {
                    const float g0 = acc[ai][0][m][0][j], g1 = acc[ai][0][m][1][j];
                    v0[j] = g0 * sigmoidf_(g0) * acc[ai][1][m][0][j]; v1[j] = g1 * sigmoidf_(g1) * acc[ai][1][m][1][j];
                }
                u32x4 w; w.x = pk2(v0[0], v0[1]); w.y = pk2(v0[2], v0[3]); w.z = pk2(v1[0], v1[1]); w.w = pk2(v1[2], v1[3]);
                *(u32x4*)rowp = w;
            }
    }
};
template <class Epi, class Sched>
__device__ __forceinline__ void gemm_phase(PG8_LAS unsigned char* lds, const Gemm g, const Sched& S, const Epi& E) {
    const int tid = threadIdx.x, wid = __builtin_amdgcn_readfirstlane(tid >> 6), lane = tid & 63, wr = wid >> 2, wc = wid & 3, fr = lane & 15, fq = lane >> 4;
    const int K = g.K, nt = K / BK;
    unsigned voffA[2], voffB[2];
#pragma unroll
    for (int i = 0; i < 2; ++i) { int R, C; stage_rc(tid * 16 + i * 8192, R, C); const int Rb = Epi::PERM ? ((R & ~31) + perm32(R & 31)) : R;
        voffA[i] = (unsigned)(R * K + C) * 2u; voffB[i] = (unsigned)(Rb * K + C) * 2u; }
    const size_t kstep = (size_t)(BK * 2);
    const size_t hstep = (size_t)HALF * K * 2;
    const size_t tstep = 2 * hstep;
    const unsigned ldsw = (unsigned)wid * 1024u;
    const int aoff = lds_byte(wr * 64 + fr, fq * 8), boff = lds_byte(wc * 32 + fr, fq * 8);
#define PG8_SA(b, h) (((b) * 2 + (h)) * HTB)
#define PG8_SB(b, h) ((4 + (b) * 2 + (h)) * HTB)
#define PG8_STAGE(bufoff, gbase, voff) do { _Pragma("unroll") for (int _i = 0; _i < 2; ++_i) \
        __builtin_amdgcn_global_load_lds((const unsigned*)((const char*)(gbase) + (voff)[_i]), (PG8_LAS unsigned*)(lds + (bufoff) + ldsw + _i * 8192), 16, 0, 0); } while (0)
#define PG8_LDA(dst, b, h) do { _Pragma("unroll") for (int m = 0; m < 4; ++m) _Pragma("unroll") for (int k = 0; k < 2; ++k) dst[m][k] = *(const PG8_LAS bf16x8*)(lds + PG8_SA(b, h) + aoff + m * 2048 + k * 1024); } while (0)
#define PG8_LDB(dst, b, h) do { _Pragma("unroll") for (int n = 0; n < 2; ++n) _Pragma("unroll") for (int k = 0; k < 2; ++k) dst[n][k] = *(const PG8_LAS bf16x8*)(lds + PG8_SB(b, h) + boff + n * 2048 + k * 1024); } while (0)
#define PG8_MMA(ai, bj, At, Bt) do { __builtin_amdgcn_s_setprio(1); _Pragma("unroll") for (int m = 0; m < 4; ++m) _Pragma("unroll") for (int n = 0; n < 2; ++n) _Pragma("unroll") for (int k = 0; k < 2; ++k) \
        acc[ai][bj][m][n] = __builtin_amdgcn_mfma_f32_16x16x32_bf16(Bt[n][k], At[m][k], acc[ai][bj][m][n], 0, 0, 0); __builtin_amdgcn_s_setprio(0); } while (0)
#define PG8_WAIT_V(n) asm volatile("s_waitcnt vmcnt(" #n ")" ::: "memory")
#define PG8_WAIT_L(n) asm volatile("s_waitcnt lgkmcnt(" #n ")" ::: "memory")
#define PG8_BAR __builtin_amdgcn_s_barrier()
#define PG8_SCHED __builtin_amdgcn_sched_barrier(0)
    Unit cur, nxt; int ui = 0;
    if (!S.next(0, cur)) return;
    f32x4 acc[2][2][4][2];
#pragma unroll
    for (int a = 0; a < 2; ++a)
#pragma unroll
        for (int b = 0; b < 2; ++b)
#pragma unroll
            for (int m = 0; m < 4; ++m)
#pragma unroll
                for (int n = 0; n < 2; ++n) acc[a][b][m][n] = (f32x4){0.f, 0.f, 0.f, 0.f};
    bf16x8 At[4][2], B0[2][2], B1[2][2];
    const char* cA = (const char*)g.A + (size_t)cur.pm * tstep; const char* cB = (const char*)g.Bt + (size_t)cur.pn * tstep;
    S.a_ready(cur);
    PG8_STAGE(PG8_SB(0, 0), cB, voffB); PG8_STAGE(PG8_SA(0, 0), cA, voffA); PG8_STAGE(PG8_SB(0, 1), cB + hstep, voffB); PG8_STAGE(PG8_SA(0, 1), cA + hstep, voffA);
    if (wr == 1) PG8_BAR;
    PG8_WAIT_V(4); PG8_BAR;
    PG8_STAGE(PG8_SB(1, 0), cB + kstep, voffB); PG8_STAGE(PG8_SA(1, 0), cA + kstep, voffA); PG8_STAGE(PG8_SB(1, 1), cB + hstep + kstep, voffB);
    PG8_WAIT_V(6); PG8_BAR;
    for (;;) {
        const bool has_next = S.next(ui + 1, nxt);
        const char* nA = has_next ? (const char*)g.A + (size_t)nxt.pm * tstep : cA; const char* nB = has_next ? (const char*)g.Bt + (size_t)nxt.pn * tstep : cB;
        for (int t = 0; t < nt; t += 2) {
            const bool last = (t == nt - 2);
            const char* a1 = cA + (size_t)(t + 1) * kstep;
            const char* a2 = last ? nA : cA + (size_t)(t + 2) * kstep; const char* b2 = last ? nB : cB + (size_t)(t + 2) * kstep;
            const char* a3 = a2 + kstep; const char* b3 = b2 + kstep;
            if (last && has_next) S.a_ready(nxt);
            PG8_LDB(B0, 0, 0); PG8_SCHED; PG8_LDA(At, 0, 0); PG8_STAGE(PG8_SA(1, 1), a1 + hstep, voffA);
            PG8_WAIT_L(8); PG8_BAR; PG8_WAIT_L(0); PG8_MMA(0, 0, At, B0); PG8_BAR; PG8_SCHED;
            PG8_LDB(B1, 0, 1); PG8_STAGE(PG8_SB(0, 0), b2, voffB);
            PG8_BAR; PG8_WAIT_L(0); PG8_MMA(0, 1, At, B1); PG8_BAR;
            PG8_LDA(At, 0, 1); PG8_STAGE(PG8_SA(0, 0), a2, voffA);
            PG8_BAR; PG8_WAIT_L(0); PG8_MMA(1, 0, At, B0); PG8_BAR; PG8_SCHED;
            PG8_STAGE(PG8_SB(0, 1), b2 + hstep, voffB);
            PG8_WAIT_V(6); PG8_BAR; PG8_MMA(1, 1, At, B1); PG8_BAR;
            PG8_LDB(B0, 1, 0); PG8_SCHED; PG8_LDA(At, 1, 0); PG8_STAGE(PG8_SA(0, 1), a2 + hstep, voffA);
            PG8_WAIT_L(8); PG8_BAR; PG8_WAIT_L(0); PG8_MMA(0, 0, At, B0); PG8_BAR; PG8_SCHED;
            PG8_LDB(B1, 1, 1); PG8_STAGE(PG8_SB(1, 0), b3, voffB);
            PG8_BAR; PG8_WAIT_L(0); PG8_MMA(0, 1, At, B1); PG8_BAR;
            PG8_LDA(At, 1, 1); PG8_STAGE(PG8_SA(1, 0), a3, voffA);
            PG8_BAR; PG8_WAIT_L(0); PG8_MMA(1, 0, At, B0); PG8_BAR; PG8_SCHED;
            PG8_STAGE(PG8_SB(1, 1), b3 + hstep, voffB);
            PG8_WAIT_V(6); PG8_BAR; PG8_MMA(1, 1, At, B1); PG8_BAR;
        }
        if constexpr (!Epi::AFTER_DRAIN) { E(acc, cur, wr, wc, fr, fq); S.done(cur); }
        if (!has_next) break;
#pragma unroll
        for (int a = 0; a < 2; ++a)
#pragma unroll
            for (int b = 0; b < 2; ++b)
#pragma unroll
                for (int m = 0; m < 4; ++m)
#pragma unroll
                    for (int n = 0; n < 2; ++n) acc[a][b][m][n] = (f32x4){0.f, 0.f, 0.f, 0.f};
        cur = nxt; cA = nA; cB = nB; ++ui;
    }
    PG8_WAIT_V(0);
    if (wr == 0) PG8_BAR;
    PG8_BAR;
    if constexpr (Epi::AFTER_DRAIN) { E.fused(acc, cur, wr, wc, fr, fq, lds, wid, lane); S.done(cur); }
#undef PG8_SA
#undef PG8_SB
#undef PG8_STAGE
#undef PG8_LDA
#undef PG8_LDB
#undef PG8_MMA
#undef PG8_WAIT_V
#undef PG8_WAIT_L
#undef PG8_BAR
#undef PG8_SCHED
}
}

DI int src_col(int kind, int n) {
    if (kind == 0) { if (n < 1024) { const int hh = n >> 7, ch = n & 127; return hh * 128 + (ch >> 1) + 64 * (ch & 1); } return n; }
    if (kind == 2) { const int pn = n >> 8, bj = (n >> 7) & 1, i = n & 127; return bj * DFF + 128 * pn + i; }
    return n;
}
DI void transpose_tile(unsigned char* lds, const float* W, bf16_t* Wt, int K, int N, int kind, int tile) {
    bf16_t* T = (bf16_t*)lds;
    const int ntk = K / 64, tn = tile / ntk, tk = tile % ntk, n0 = tn * 64, k0 = tk * 64, tid = threadIdx.x;
#pragma unroll
    for (int e = 0; e < 8; ++e) {
        const int idx = tid + NTHR * e, kk = idx >> 6, nn = idx & 63;
        T[nn * 72 + kk] = f2bf(W[(size_t)(k0 + kk) * N + src_col(kind, n0 + nn)]);
    }
    __syncthreads();
    { const int nn = tid >> 3, seg = tid & 7; *(u32x4*)(Wt + (size_t)(n0 + nn) * K + k0 + 8 * seg) = *(const u32x4*)(T + nn * 72 + 8 * seg); }
    __syncthreads();
}
DI void mod_item(unsigned char* lds, const Params& p, int item) {
    float* S = (float*)lds;
    float* R = S + 9 * 1024;
    const int tid = threadIdx.x;
    for (int i = tid; i < 9 * 1024; i += NTHR) { const float v = i < 8192 ? p.in[1][i] : p.in[3][i - 8192]; S[i] = v / (1.0f + __expf(-v)); }
    __syncthreads();
    const int nn = tid & 63, ks = tid >> 6, n = item * 64 + nn;
    float acc[9];
#pragma unroll
    for (int r = 0; r < 9; ++r) acc[r] = 0.f;
    const float* wm = p.in[4] + n;
#pragma unroll 4
    for (int kk = 0; kk < 128; ++kk) {
        const int k = ks * 128 + kk; const float w = wm[(size_t)k * 6144];
#pragma unroll
        for (int r = 0; r < 9; ++r) acc[r] += S[r * 1024 + k] * w;
    }
#pragma unroll
    for (int r = 0; r < 9; ++r) R[(ks * 9 + r) * 64 + nn] = acc[r];
    __syncthreads();
    for (int i = tid; i < 9 * 64; i += NTHR) {
        const int r = i >> 6, c = i & 63; float s = p.in[5][item * 64 + c];
#pragma unroll
        for (int k2 = 0; k2 < 8; ++k2) s += R[(k2 * 9 + r) * 64 + c];
        ((float*)(p.ws + WS_MOD))[r * 6144 + item * 64 + c] = s;
    }
    __syncthreads();
}
DI void filt_item(unsigned char* lds, const Params& p, int item) {
    float* E = (float*)lds;
    float* H1 = E + 8 * 36;
    float* H2 = H1 + 512;
    const int tid = threadIdx.x, tt = tid >> 6, j = tid & 63, t = item * 8 + tt;
    if (j < 33) {
        float v;
        if (j == 0) v = (float)((double)t / 4095.0);
        else {
            const int bi = (j - 1) & 15;
            const double f = (double)(1e-4f) + (double)bi * (((double)15.0f - (double)1e-4f) / 15.0);
            double xr = f * (double)t * (1.0 / 4096.0); xr -= floor(xr);
            const float ang = 6.283185307179586f * (float)xr;
            v = j <= 16 ? cosf(ang) : -sinf(ang);
        }
        E[tt * 36 + j] = v;
    }
    __syncthreads();
    const float fr = p.in[20][j];
    { float a = p.in[14][j];
_Pragma("unroll 4") for (int i = 0; i < 33; ++i) a += E[tt * 36 + i] * p.in[13][i * 64 + j]; H1[tt * 64 + j] = sinf(fr * a); }
    __syncthreads();
    { float a = p.in[16][j];
_Pragma("unroll 4") for (int i = 0; i < 64; ++i) a += H1[tt * 64 + i] * p.in[15][i * 64 + j]; H2[tt * 64 + j] = sinf(fr * a); }
    __syncthreads();
    { float a = p.in[18][j];
_Pragma("unroll 4") for (int i = 0; i < 64; ++i) a += H2[tt * 64 + i] * p.in[17][i * 64 + j]; ((float*)(p.ws + WS_FH3))[(size_t)t * 64 + j] = sinf(fr * a); }
    __syncthreads();
}
constexpr int T_WIN = (DIN / 64) * (DM / 64), T_WOUT = (DM / 64) * (DM / 64), T_WGU = (2 * DFF / 64) * (DM / 64), T_WDN = (DM / 64) * (DFF / 64);
DI void phase0(unsigned char* lds, const Params& p) {
    const int tid = threadIdx.x;
    { float* rope = (float*)(p.ws + WS_ROPE);
      for (int idx = blockIdx.x * NTHR + tid; idx < SEQ * 64; idx += gridDim.x * NTHR) {
          const int t = idx >> 6, m = idx & 63, row = t >> 6, col = t & 63;
          const float inv = powf(10000.0f, -(float)(m & 31) / 32.0f);
          const float ang = (float)(m < 32 ? row : col) * inv;
          rope[2 * idx] = cosf(ang); rope[2 * idx + 1] = sinf(ang);
      }
      if (blockIdx.x == 0) { for (int i = tid; i < 512 + 1024; i += NTHR) ((float*)(p.ws + WS_KSUM))[i] = 0.f; } }
    const int n_items = 96 + 512 + T_WIN + T_WOUT + T_WGU + T_WDN;
    for (int it = blockIdx.x; it < n_items; it += gridDim.x) {
        int i = it;
        if (i < 96) { mod_item(lds, p, i); continue; } i -= 96;
        if (i < 512) { filt_item(lds, p, i); continue; } i -= 512;
        if (i < T_WIN) { transpose_tile(lds, p.in[8], (bf16_t*)(p.ws + WS_WIN), DM, DIN, 0, i); continue; } i -= T_WIN;
        if (i < T_WOUT) { transpose_tile(lds, p.in[23], (bf16_t*)(p.ws + WS_WOUT), DM, DM, 1, i); continue; } i -= T_WOUT;
        if (i < T_WGU) { transpose_tile(lds, p.in[24], (bf16_t*)(p.ws + WS_WGU), DM, 2 * DFF, 2, i); continue; } i -= T_WGU;
        transpose_tile(lds, p.in[25], (bf16_t*)(p.ws + WS_WDN), DFF, DM, 3, i);
    }
}

DI void norm_rows(const float* src, bf16_t* dst, int row_lo, int row_hi, const float* gain, const float* mod, int shift_i, int scale_i, int ctx_row) {
    const int lane = threadIdx.x & 63, w = threadIdx.x >> 6;
    for (int row = row_lo + blockIdx.x * 8 + w; row < row_hi; row += gridDim.x * 8) {
        const int mr = ctx_row >= 0 ? ctx_row : (row >> 12);
        const float* s = src + (size_t)(row - row_lo) * DM;
        f32x4 v[4]; float ss = 0.f;
#pragma unroll
        for (int k = 0; k < 4; ++k) { v[k] = *(const f32x4*)(s + 4 * lane + 256 * k); ss += v[k][0] * v[k][0] + v[k][1] * v[k][1] + v[k][2] * v[k][2] + v[k][3] * v[k][3]; }
        ss = wave_sum(ss);
        const float rstd = rsqrtf(ss * (1.0f / DM) + EPSF);
#pragma unroll
        for (int k = 0; k < 4; ++k) {
            const int c = 4 * lane + 256 * k;
            const f32x4 g = *(const f32x4*)(gain + c), sh = *(const f32x4*)(mod + (size_t)mr * 6144 + shift_i * 1024 + c), sc = *(const f32x4*)(mod + (size_t)mr * 6144 + scale_i * 1024 + c);
            const f32x4 h = v[k] * rstd * g * (sc + 1.0f) + sh;
            u32x2 o; o.x = pk2(h[0], h[1]); o.y = pk2(h[2], h[3]);
            *(u32x2*)(dst + (size_t)row * DM + c) = o;
        }
    }
}
DI void filt4_item(unsigned char* lds, const Params& p, int item) {
    float* F = (float*)lds;
    const int tid = threadIdx.x, tt = item >> 1, dir = item & 1, t0 = tt * 32, c = tid;
    for (int i = tid; i < 32 * 64; i += NTHR) F[i] = ((const float*)(p.ws + WS_FH3))[(size_t)t0 * 64 + i];
    __syncthreads();
    float w4[64];
#pragma unroll
    for (int j = 0; j < 64; ++j) w4[j] = p.in[19][(size_t)j * 1024 + dir * 512 + c];
    const float mind = logf(0.01f) / 1.5f, maxd = logf(0.01f) / 0.3f;
    const float ad = fabsf(mind + (float)c * ((maxd - mind) / 511.0f));
    float* dst = (float*)(p.ws + WS_KERN) + ((size_t)dir * 512 + c) * SEQ + t0;
    float asum = 0.f;
#pragma unroll 1
    for (int q = 0; q < 8; ++q) {
        f32x4 o;
#pragma unroll
        for (int r = 0; r < 4; ++r) {
            const int tl = q * 4 + r; float a = 0.f;
#pragma unroll
            for (int j = 0; j < 64; ++j) a += F[tl * 64 + j] * w4[j];
            const float tlin = (float)(t0 + tl) / 4095.0f;
            a *= __expf(-tlin * ad);
            o[r] = a;
            if (!(dir == 1 && t0 + tl == 0)) asum += fabsf(a);
        }
        *(f32x4*)(dst + q * 4) = o;
    }
    atomicAdd((float*)(p.ws + WS_KSUM) + c, asum);
    __syncthreads();
}
DI void phase1(unsigned char* lds, const Params& p) {
    for (int it = blockIdx.x; it < 256; it += gridDim.x) filt4_item(lds, p, it);
    const float* mod = (const float*)(p.ws + WS_MOD);
    bf16_t* HA = (bf16_t*)(p.ws + WS_HA);
    norm_rows(p.in[0], HA, 0, MTOK, p.in[6], mod, 0, 1, -1);
    norm_rows(p.in[2], HA, MTOK, MTOK + MCTX, p.in[6], mod, 0, 1, 8);
}

DI void ret_state_item(unsigned char* lds, const Params& p, int item) {
    const int tid = threadIdx.x, lane = tid & 63, w = tid >> 6;
    const int b = item >> 5, h = (item >> 3) & 3, dir = (item >> 2) & 1, eq = item & 3, bh = b * 4 + h;
    const bf16_t* P = (const bf16_t*)(p.ws + WS_P);
    const bf16_t* KVC = (const bf16_t*)(p.ws + WS_KVC);
    bf16_t* ST = (bf16_t*)(p.ws + WS_ST);
    unsigned char* KI = lds;
    unsigned char* VI = lds + 128 * 272;
    const float lg = log1pf(-__expf(p.in[9][dir * 4 + h]));
    const float g128 = __expf(lg * 128.0f);
    const int jv = tid >> 2, segv = tid & 3;
    const float wv = dir == 0 ? __expf(lg * (float)(127 - jv)) : __expf(lg * (float)jv);
    const int segk = tid & 15, jk0 = tid >> 4;
    u32x4 kreg[4], vreg;
    f32x4 acc[2] = {{0.f, 0.f, 0.f, 0.f}, {0.f, 0.f, 0.f, 0.f}};
    const int G = lane >> 4, i16 = lane & 15, q = i16 >> 2, pp = i16 & 3;
#define RS_LOAD(s) do { \
        const bf16_t* kb; const bf16_t* vb; size_t ld; \
        if ((s) < 2) { const int cc = dir == 0 ? (s) : 1 - (s); kb = KVC + (size_t)(b * CTXL + cc * 128) * 1024 + h * 128; vb = kb + 512 + 32 * eq; ld = 1024; } \
        else { const int n = dir == 0 ? (s) - 2 : 31 - ((s) - 2); kb = P + (size_t)(b * SEQ + n * 128) * DIN + 512 + h * 128; vb = kb + 512 + 32 * eq; ld = DIN; } \
        _Pragma("unroll") for (int i = 0; i < 4; ++i) kreg[i] = *(const u32x4*)(kb + (size_t)(jk0 + 32 * i) * ld + 8 * segk); \
        vreg = *(const u32x4*)(vb + (size_t)jv * ld + 8 * segv); } while (0)
    RS_LOAD(0);
    for (int s = 0; s < 34; ++s) {
        if (s >= 2) {
            const int n = dir == 0 ? s - 2 : 31 - (s - 2);
            bf16_t* dst = ST + (((size_t)dir * 32 + bh) * 32 + n) * 16384;
#pragma unroll
            for (int et = 0; et < 2; ++et)
#pragma unroll
                for (int r = 0; r < 4; ++r) dst[(size_t)(32 * eq + 16 * et + 4 * G + r) * 128 + 16 * w + i16] = f2bf(acc[et][r]);
        }
        if (s == 33) break;
#pragma unroll
        for (int i = 0; i < 4; ++i) *(u32x4*)(KI + (jk0 + 32 * i) * 272 + segk * 16) = kreg[i];
        { u32x4 o; o.x = pk2(bflo(vreg.x) * wv, bfhi(vreg.x) * wv); o.y = pk2(bflo(vreg.y) * wv, bfhi(vreg.y) * wv); o.z = pk2(bflo(vreg.z) * wv, bfhi(vreg.z) * wv); o.w = pk2(bflo(vreg.w) * wv, bfhi(vreg.w) * wv);
          *(u32x4*)(VI + jv * 80 + segv * 16) = o; }
        __syncthreads();
        if (s + 1 < 33) RS_LOAD(s + 1);
        acc[0] *= g128; acc[1] *= g128;
        const LAS unsigned char* kbase = (const LAS unsigned char*)KI; const LAS unsigned char* vbase = (const LAS unsigned char*)VI;
#pragma unroll
        for (int ks = 0; ks < 4; ++ks) {
            const int j0 = 32 * ks + 8 * G + q;
            const bf16x8 bk = tr_read8(kbase + j0 * 272 + (16 * w + 4 * pp) * 2, 4 * 272);
#pragma unroll
            for (int et = 0; et < 2; ++et) {
                const bf16x8 av = tr_read8(vbase + j0 * 80 + (16 * et + 4 * pp) * 2, 4 * 80);
                acc[et] = MFMA16(av, bk, acc[et]);
            }
        }
        __syncthreads();
    }
#undef RS_LOAD
}

DI void hy_u_item(unsigned char* lds, const Params& p, int item) {
    bf16_t* T = (bf16_t*)lds;
    const int tid = threadIdx.x, lane = tid & 63, w = tid >> 6;
    const int b = item >> 9, tt = (item >> 3) & 63, ct = item & 7, t0 = tt * 64, c = ct * 64 + lane;
    const bf16_t* P = (const bf16_t*)(p.ws + WS_P) + (size_t)b * SEQ * DIN + 2048;
    const float* sw = p.in[11]; const float* sb = p.in[12];
    const int c1 = 512 + c, c2 = 1024 + c;
    const float w10 = sw[c1], w11 = sw[1536 + c1], w12 = sw[3072 + c1], b1 = sb[c1];
    const float w20 = sw[c2], w21 = sw[1536 + c2], w22 = sw[3072 + c2], b2 = sb[c2];
    const int ts = t0 + 8 * w;
    float x1m, x1c, vm, vc;
    { const int t = ts - 1; x1m = t >= 0 ? bf2f(P[(size_t)t * DIN + c1]) : 0.f; vm = t >= 0 ? bf2f(P[(size_t)t * DIN + c2]) : 0.f; }
    x1c = bf2f(P[(size_t)ts * DIN + c1]); vc = bf2f(P[(size_t)ts * DIN + c2]);
#pragma unroll
    for (int r = 0; r < 8; ++r) {
        const int t = ts + r + 1;
        const float x1n = t < SEQ ? bf2f(P[(size_t)t * DIN + c1]) : 0.f, vn = t < SEQ ? bf2f(P[(size_t)t * DIN + c2]) : 0.f;
        const float x1 = b1 + w10 * x1m + w11 * x1c + w12 * x1n, v = b2 + w20 * vm + w21 * vc + w22 * vn;
        T[lane * 72 + 8 * w + r] = f2bf(v * x1);
        x1m = x1c; x1c = x1n; vm = vc; vc = vn;
    }
    __syncthreads();
    { const int cc = tid >> 3, seg = tid & 7;
      *(u32x4*)((bf16_t*)(p.ws + WS_U) + ((size_t)(ct * 64 + cc) * NB + b) * SEQ + t0 + 8 * seg) = *(const u32x4*)(T + cc * 72 + 8 * seg); }
    __syncthreads();
}

DI void ret_out_item(unsigned char* lds, const Params& p, int item) {
    const int tid = threadIdx.x, lane = tid & 63, w = tid >> 6;
    const int b = item >> 7, h = (item >> 5) & 3, n = item & 31, bh = b * 4 + h;
    const bf16_t* P = (const bf16_t*)(p.ws + WS_P);
    const bf16_t* ST = (const bf16_t*)(p.ws + WS_ST);
    bf16_t* MIX = (bf16_t*)(p.ws + WS_MIXIN);
    unsigned char* KB = lds;
    unsigned char* VB = lds + 34816;
    unsigned char* SF = lds + 2 * 34816;
    unsigned char* PI = lds + 3 * 34816 + w * 5120;
    const float lgf = log1pf(-__expf(p.in[9][h])), lgb = log1pf(-__expf(p.in[9][4 + h]));
    const float lf2 = lgf * 1.4426950408889634f, lb2 = lgb * 1.4426950408889634f;
    const size_t tok0 = (size_t)b * SEQ + n * 128;
    const int G = lane >> 4, i16 = lane & 15, q = i16 >> 2, pp = i16 & 3;
    const int segk = tid & 15, jk0 = tid >> 4;
    { const bf16_t* kb = P + tok0 * DIN + 512 + h * 128; const bf16_t* vb = kb + 512;
      const bf16_t* sf = ST + (((size_t)0 * 32 + bh) * 32 + n) * 16384;
#pragma unroll
      for (int i = 0; i < 4; ++i) {
          const int j = jk0 + 32 * i;
          *(u32x4*)(KB + j * 272 + segk * 16) = *(const u32x4*)(kb + (size_t)j * DIN + 8 * segk);
          *(u32x4*)(VB + j * 272 + segk * 16) = *(const u32x4*)(vb + (size_t)j * DIN + 8 * segk);
          *(u32x4*)(SF + j * 272 + segk * 16) = *(const u32x4*)(sf + (size_t)j * 128 + 8 * segk);
      } }
    bf16x8 qf[4];
    { const bf16_t* qb = P + (tok0 + 16 * w + i16) * DIN + h * 128 + 8 * G;
#pragma unroll
      for (int ks = 0; ks < 4; ++ks) qf[ks] = *(const bf16x8*)(qb + 32 * ks); }
    __syncthreads();
    int ibase = 16 * w + 4 * G;
    asm volatile("" : "+v"(ibase));
    {
        f32x4 accS[8];
#pragma unroll
        for (int jt = 0; jt < 8; ++jt) {
            accS[jt] = (f32x4){0.f, 0.f, 0.f, 0.f};
#pragma unroll
            for (int ks = 0; ks < 4; ++ks) { const bf16x8 bk = *(const bf16x8*)(KB + (16 * jt + i16) * 272 + (32 * ks + 8 * G) * 2); accS[jt] = MFMA16(qf[ks], bk, accS[jt]); }
            if (jt & 1) __builtin_amdgcn_sched_barrier(0);
        }
#pragma unroll
        for (int jt = 0; jt < 8; ++jt) {
            const int j = 16 * jt + i16; float pv[4];
#pragma unroll
            for (int r = 0; r < 4; ++r) {
                const int diff = ibase + r - j;
                const float ex = exp2f((diff > 0 ? lf2 : -lb2) * (float)diff);
                pv[r] = accS[jt][r] * (diff == 0 ? 2.0f : ex);
            }
            u32x2 o; o.x = pk2(pv[0], pv[1]); o.y = pk2(pv[2], pv[3]);
            *(u32x2*)(PI + j * 40 + 8 * G) = o;
        }
    }
    __syncthreads();
    { const bf16_t* sbp = ST + (((size_t)1 * 32 + bh) * 32 + n) * 16384;
#pragma unroll
      for (int i = 0; i < 4; ++i) { const int j = jk0 + 32 * i; *(u32x4*)(KB + j * 272 + segk * 16) = *(const u32x4*)(sbp + (size_t)j * 128 + 8 * segk); } }
    f32x4 accI[8];
    const LAS unsigned char* pbase = (const LAS unsigned char*)PI; const LAS unsigned char* vbase = (const LAS unsigned char*)VB;
#pragma unroll
    for (int et = 0; et < 8; ++et) accI[et] = (f32x4){0.f, 0.f, 0.f, 0.f};
#pragma unroll
    for (int ks = 0; ks < 4; ++ks) {
        const int j0 = 32 * ks + 8 * G + q;
        const bf16x8 ap = tr_read8(pbase + j0 * 40 + 8 * pp, 4 * 40);
#pragma unroll
        for (int et = 0; et < 8; ++et) {
            const bf16x8 bv = tr_read8(vbase + j0 * 272 + (16 * et + 4 * pp) * 2, 4 * 272);
            accI[et] = MFMA16(ap, bv, accI[et]);
        }
        __builtin_amdgcn_sched_barrier(0);
    }
    float cf[4], cb[4];
#pragma unroll
    for (int r = 0; r < 4; ++r) { const int i = ibase + r; cf[r] = exp2f(lf2 * (float)(i + 1)); cb[r] = exp2f(lb2 * (float)(128 - i)); }
#pragma unroll
    for (int et = 0; et < 8; ++et) {
        f32x4 accX = (f32x4){0.f, 0.f, 0.f, 0.f};
#pragma unroll
        for (int ks = 0; ks < 4; ++ks) { const bf16x8 bs = *(const bf16x8*)(SF + (16 * et + i16) * 272 + (32 * ks + 8 * G) * 2); accX = MFMA16(qf[ks], bs, accX); }
#pragma unroll
        for (int r = 0; r < 4; ++r) accI[et][r] += cf[r] * accX[r];
        if (et & 1) __builtin_amdgcn_sched_barrier(0);
    }
    __syncthreads();
#pragma unroll
    for (int et = 0; et < 8; ++et) {
        f32x4 accX = (f32x4){0.f, 0.f, 0.f, 0.f};
#pragma unroll
        for (int ks = 0; ks < 4; ++ks) { const bf16x8 bs = *(const bf16x8*)(KB + (16 * et + i16) * 272 + (32 * ks + 8 * G) * 2); accX = MFMA16(qf[ks], bs, accX); }
#pragma unroll
        for (int r = 0; r < 4; ++r) accI[et][r] += cb[r] * accX[r];
        if (et & 1) __builtin_amdgcn_sched_barrier(0);
    }
    const float* gn = p.in[10] + h * 128;
#pragma unroll
    for (int r = 0; r < 4; ++r) {
        float s = 0.f;
#pragma unroll
        for (int et = 0; et < 8; ++et) s += accI[et][r];
        s += __shfl_xor(s, 1); s += __shfl_xor(s, 2); s += __shfl_xor(s, 4); s += __shfl_xor(s, 8);
        const float mu = s * (1.0f / 128.0f);
        float v = 0.f;
#pragma unroll
        for (int et = 0; et < 8; ++et) { const float d = accI[et][r] - mu; v += d * d; }
        v += __shfl_xor(v, 1); v += __shfl_xor(v, 2); v += __shfl_xor(v, 4); v += __shfl_xor(v, 8);
        const float rstd = rsqrtf(v * (1.0f / 128.0f) + EPSF);
        const size_t tok = tok0 + 16 * w + 4 * G + r;
#pragma unroll
        for (int et = 0; et < 8; ++et) {
            const int e = 16 * et + i16;
            const float g = bf2f(P[tok * DIN + 1536 + h * 128 + e]);
            MIX[tok * DM + h * 128 + e] = f2bf((accI[et][r] - mu) * rstd * gn[e] * (g * sigmoidf_(g)));
        }
        __builtin_amdgcn_sched_barrier(0);
    }
    __syncthreads();
}

constexpr int KR_OFF = 4112, KR_N = 8208, KR_BYTES = 16640, USH_ROW = 528, USH_BYTES = 64 * USH_ROW;
DI void conv_item(unsigned char* lds, const Params& p, int c) {
    const int tid = threadIdx.x, lane = tid & 63, w = tid >> 6;
    bf16_t* KR = (bf16_t*)lds;
    unsigned char* USH = lds + KR_BYTES;
    const bf16_t* Ug = (const bf16_t*)(p.ws + WS_U) + (size_t)c * NB * SEQ;
    bf16_t* Yg = (bf16_t*)(p.ws + WS_YC) + (size_t)c * NB * SEQ;
    { const float* kf = (const float*)(p.ws + WS_KERN) + (size_t)c * SEQ; const float* kb = kf + (size_t)512 * SEQ;
      const float sc = 1.0f / (((const float*)(p.ws + WS_KSUM))[c] + EPSF);
      for (int y = tid; y < KR_N + 8; y += NTHR) {
          const int m = KR_OFF - y; float v = 0.f;
          if (m >= 0 && m < SEQ) v = kf[m] * sc; else if (m < 0 && m > -SEQ) v = kb[-m] * sc;
          KR[y] = f2bf(v);
      } }
    const int rh = tid >> 8, sb = (tid >> 5) & 7, sg = tid & 31;
    u32x4 lo, hi;
#define CV_LOAD(qc) do { const int e0 = -16 + 256 * (qc) + 8 * sg, e1 = e0 + 8; \
        lo = (e0 >= 0 && e0 < SEQ) ? *(const u32x4*)(Ug + (size_t)sb * SEQ + e0) : (u32x4){0u, 0u, 0u, 0u}; \
        hi = (e1 >= 0 && e1 < SEQ) ? *(const u32x4*)(Ug + (size_t)sb * SEQ + e1) : (u32x4){0u, 0u, 0u, 0u}; } while (0)
#define CV_WIN(r, dst) do { const unsigned wv[8] = {lo.x, lo.y, lo.z, lo.w, hi.x, hi.y, hi.z, hi.w}; constexpr int e_ = (r) >> 1; u32x4 o_; \
        if ((r) & 1) { o_.x = (wv[e_] >> 16) | (wv[e_ + 1] << 16); o_.y = (wv[e_ + 1] >> 16) | (wv[e_ + 2] << 16); o_.z = (wv[e_ + 2] >> 16) | (wv[e_ + 3] << 16); o_.w = (wv[e_ + 3] >> 16) | (wv[e_ + 4] << 16); } \
        else { o_.x = wv[e_]; o_.y = wv[e_ + 1]; o_.z = wv[e_ + 2]; o_.w = wv[e_ + 3]; } \
        *(u32x4*)((dst) + ((r) * 8 + sb) * USH_ROW + sg * 16) = o_; } while (0)
#define CV_STORE(buf) do { unsigned char* d_ = USH + (buf) * USH_BYTES; \
        if (rh == 0) { CV_WIN(0, d_); CV_WIN(1, d_); CV_WIN(2, d_); CV_WIN(3, d_); } else { CV_WIN(4, d_); CV_WIN(5, d_); CV_WIN(6, d_); CV_WIN(7, d_); } } while (0)
    f32x16 acc[2][2];
#pragma unroll
    for (int a = 0; a < 2; ++a)
#pragma unroll
        for (int b2 = 0; b2 < 2; ++b2)
#pragma unroll
            for (int k = 0; k < 16; ++k) acc[a][b2][k] = 0.f;
    const int i32 = lane & 31, hh = lane >> 5;
    const int ya0 = KR_OFF - 256 * (2 * w) - 8 * i32 - 16 + 8 * hh, ya1 = ya0 - 256;
    const int brow0 = ((i32 & 7) * 8 + (i32 >> 3)) * USH_ROW + hh * 16, brow1 = brow0 + 4 * USH_ROW;
    CV_LOAD(0);
    CV_STORE(0);
    __syncthreads();
    for (int qc = 0; qc < 17; ++qc) {
        if (qc + 1 < 17) CV_LOAD(qc + 1);
        const unsigned char* ub = USH + (qc & 1) * USH_BYTES;
        const int nst = qc < 16 ? 16 : 1;
        for (int st = 0; st < nst; ++st) {
            const int sg16 = (qc * 16 + st) * 16;
            const bf16x8 a0 = *(const bf16x8*)(KR + ya0 + sg16), a1 = *(const bf16x8*)(KR + ya1 + sg16);
            const bf16x8 b0 = *(const bf16x8*)(ub + brow0 + st * 32), b1 = *(const bf16x8*)(ub + brow1 + st * 32);
            acc[0][0] = MFMA32(a0, b0, acc[0][0]); acc[0][1] = MFMA32(a0, b1, acc[0][1]);
            acc[1][0] = MFMA32(a1, b0, acc[1][0]); acc[1][1] = MFMA32(a1, b1, acc[1][1]);
        }
        if (qc + 1 < 17) CV_STORE((qc + 1) & 1);
        __syncthreads();
    }
#pragma unroll
    for (int mi = 0; mi < 2; ++mi)
#pragma unroll
        for (int nt = 0; nt < 2; ++nt)
#pragma unroll
            for (int reg = 0; reg < 16; ++reg) {
                const int i = (reg & 3) + 8 * (reg >> 2) + 4 * hh, bb = 4 * nt + (i32 >> 3), r = i32 & 7;
                Yg[(size_t)bb * SEQ + 256 * (2 * w + mi) + 8 * i + r] = f2bf(acc[mi][nt][reg]);
            }
    __syncthreads();
#undef CV_LOAD
#undef CV_WIN
#undef CV_STORE
}

DI void hy_fin_item(unsigned char* lds, const Params& p, int item) {
    float* Z = (float*)lds;
    const int tid = threadIdx.x, lane = tid & 63, w = tid >> 6;
    const int b = item >> 6, t0 = (item & 63) * 64;
    { const int c = tid; const float bias = p.in[21][c];
      const bf16_t* yc = (const bf16_t*)(p.ws + WS_YC) + ((size_t)c * NB + b) * SEQ + t0;
      const bf16_t* uu = (const bf16_t*)(p.ws + WS_U) + ((size_t)c * NB + b) * SEQ + t0;
#pragma unroll 2
      for (int seg = 0; seg < 8; ++seg) {
          const u32x4 yv = *(const u32x4*)(yc + 8 * seg), uv = *(const u32x4*)(uu + 8 * seg);
          const unsigned ya[4] = {yv.x, yv.y, yv.z, yv.w}, ua[4] = {uv.x, uv.y, uv.z, uv.w};
#pragma unroll
          for (int k = 0; k < 4; ++k) {
              Z[(8 * seg + 2 * k) * 516 + c] = bflo(ya[k]) + bflo(ua[k]) * bias;
              Z[(8 * seg + 2 * k + 1) * 516 + c] = bfhi(ya[k]) + bfhi(ua[k]) * bias;
          }
      } }
    __syncthreads();
    const bf16_t* P = (const bf16_t*)(p.ws + WS_P) + (size_t)b * SEQ * DIN + 2048;
    bf16_t* MIX = (bf16_t*)(p.ws + WS_MIXIN) + (size_t)b * SEQ * DM + 512;
    const float* sw = p.in[11]; const float* sb = p.in[12]; const float* og = p.in[22];
    for (int tt = 0; tt < 8; ++tt) {
        const int tl = 8 * w + tt, t = t0 + tl;
        float y[8]; float ss = 0.f;
#pragma unroll
        for (int k = 0; k < 8; ++k) {
            const int c = lane + 64 * k;
            const float am = t > 0 ? bf2f(P[(size_t)(t - 1) * DIN + c]) : 0.f, a0 = bf2f(P[(size_t)t * DIN + c]), ap = t < SEQ - 1 ? bf2f(P[(size_t)(t + 1) * DIN + c]) : 0.f;
            const float x0 = sb[c] + sw[c] * am + sw[1536 + c] * a0 + sw[3072 + c] * ap;
            y[k] = x0 * Z[tl * 516 + c]; ss += y[k] * y[k];
        }
        ss = wave_sum(ss);
        const float rstd = rsqrtf(ss * (1.0f / 512.0f) + EPSF);
#pragma unroll
        for (int k = 0; k < 8; ++k) { const int c = lane + 64 * k; MIX[(size_t)t * DM + c] = f2bf(y[k] * rstd * og[c]); }
    }
    __syncthreads();
}

DI void final_norm_rows(float* io, const float* gain) {
    const int lane = threadIdx.x & 63, w = threadIdx.x >> 6;
    for (int row = blockIdx.x * 8 + w; row < MTOK; row += gridDim.x * 8) {
        float* s = io + (size_t)row * DM;
        f32x4 v[4]; float ss = 0.f;
#pragma unroll
        for (int k = 0; k < 4; ++k) { v[k] = *(const f32x4*)(s + 4 * lane + 256 * k); ss += v[k][0] * v[k][0] + v[k][1] * v[k][1] + v[k][2] * v[k][2] + v[k][3] * v[k][3]; }
        ss = wave_sum(ss);
        const float rstd = rsqrtf(ss * (1.0f / DM) + EPSF);
#pragma unroll
        for (int k = 0; k < 4; ++k) { const f32x4 g = *(const f32x4*)(gain + 4 * lane + 256 * k); *(f32x4*)(s + 4 * lane + 256 * k) = v[k] * rstd * g; }
    }
}

#ifndef PH_LO
#define PH_LO 0
#endif
#ifndef PH_HI
#define PH_HI 11
#endif

__global__ void __launch_bounds__(NTHR, 2) fwd_kernel(Params p, int ph_lo, int ph_hi) {
    extern __shared__ __attribute__((aligned(16))) unsigned char lds[];
    cg::grid_group grid = cg::this_grid();
    LAS unsigned char* lds3 = (LAS unsigned char*)lds;
    unsigned char* ws = p.ws;
    const float* MOD = (const float*)(ws + WS_MOD);
#ifndef ONLYPH
#define ONLYPH -1
#endif
#define RUN(k) ((ONLYPH < 0 || ONLYPH == (k)) && ph_lo <= (k) && (k) < ph_hi)
#define SEAM(k) do { if (RUN(k) && RUN((k) + 1)) grid.sync(); } while (0)
    if (RUN(0)) phase0(lds, p);
    SEAM(0);
    if (RUN(1)) phase1(lds, p);
    SEAM(1);
    if (RUN(2)) {
        { pg8::Gemm g{(const bf16_t*)(ws + WS_HA), (const bf16_t*)(ws + WS_WIN), MTOK, DIN, DM}; pg8::StaticOrder S; S.init(MTOK, DIN, gridDim.x, blockIdx.x);
          pg8::EpiP E{(bf16_t*)(ws + WS_P), (const float*)(ws + WS_ROPE)};
          pg8::gemm_phase<pg8::EpiP, pg8::StaticOrder>(lds3, g, S, E); }
        { pg8::Gemm g{(const bf16_t*)(ws + WS_HA) + (size_t)MTOK * DM, (const bf16_t*)(ws + WS_WIN) + (size_t)512 * DM, MCTX, 1024, DM}; pg8::StaticOrder S; S.init(MCTX, 1024, gridDim.x, blockIdx.x);
          pg8::EpiKV E{(bf16_t*)(ws + WS_KVC)};
          pg8::gemm_phase<pg8::EpiKV, pg8::StaticOrder>(lds3, g, S, E); }
    }
    SEAM(2);
    if (RUN(3)) {
        for (int it = blockIdx.x; it < 256; it += gridDim.x) ret_state_item(lds, p, it);
        for (int it = blockIdx.x; it < 4096; it += gridDim.x) hy_u_item(lds, p, it);
    }
    SEAM(3);
    if (RUN(4)) {
#ifndef NO_CONV
        for (int it = blockIdx.x; it < 512; it += gridDim.x) conv_item(lds, p, it);
#endif
#ifndef NO_RETOUT
        for (int it = blockIdx.x; it < 1024; it += gridDim.x) ret_out_item(lds, p, it);
#endif
    }
    SEAM(4);
    if (RUN(5)) { for (int it = blockIdx.x; it < 512; it += gridDim.x) hy_fin_item(lds, p, it); }
    SEAM(5);
    if (RUN(6)) {
        pg8::Gemm g{(const bf16_t*)(ws + WS_MIXIN), (const bf16_t*)(ws + WS_WOUT), MTOK, DM, DM}; pg8::StaticOrder S; S.init(MTOK, DM, gridDim.x, blockIdx.x);
        pg8::EpiRes E{p.in[0], p.out, MOD + 2 * 1024};
        pg8::gemm_phase<pg8::EpiRes, pg8::StaticOrder>(lds3, g, S, E);
    }
    SEAM(6);
    if (RUN(7)) norm_rows(p.out, (bf16_t*)(ws + WS_H2), 0, MTOK, p.in[7], MOD, 3, 4, -1);
    SEAM(7);
    if (RUN(8)) {
        pg8::Gemm g{(const bf16_t*)(ws + WS_H2), (const bf16_t*)(ws + WS_WGU), MTOK, 2 * DFF, DM}; pg8::StaticOrder S; S.init(MTOK, 2 * DFF, gridDim.x, blockIdx.x);
        pg8::EpiSwiGLU E{(bf16_t*)(ws + WS_ACT)};
        pg8::gemm_phase<pg8::EpiSwiGLU, pg8::StaticOrder>(lds3, g, S, E);
    }
    SEAM(8);
    if (RUN(9)) {
        pg8::Gemm g{(const bf16_t*)(ws + WS_ACT), (const bf16_t*)(ws + WS_WDN), MTOK, DM, DFF}; pg8::StaticOrder S; S.init(MTOK, DM, gridDim.x, blockIdx.x);
        pg8::EpiRes E{p.out, p.out, MOD + 5 * 1024};
        pg8::gemm_phase<pg8::EpiRes, pg8::StaticOrder>(lds3, g, S, E);
    }
    SEAM(9);
    if (RUN(10)) final_norm_rows(p.out, p.in[26]);
#undef RUN
#undef SEAM
}

extern "C" void kernel_launch(void* const* d_in, const int* in_sizes, int n_in, void* d_out, int out_size, void* d_ws, size_t ws_size, hipStream_t stream) {
    static int grid = 0;
    if (grid == 0) {
        if (n_in != 27 || ws_size < WS_END) { fprintf(stderr, "kernel_launch: unexpected n_in %d or ws_size %zu (< %zu)\n", n_in, ws_size, (size_t)WS_END); grid = -1; return; }
        int dev = 0, cus = 0, per_cu = 0;
        hipGetDevice(&dev);
        hipDeviceGetAttribute(&cus, hipDeviceAttributeMultiprocessorCount, dev);
        if (hipFuncSetAttribute((const void*)fwd_kernel, hipFuncAttributeMaxDynamicSharedMemorySize, LDS_BYTES) != hipSuccess) { fprintf(stderr, "kernel_launch: hipFuncSetAttribute failed\n"); grid = -1; return; }
        hipOccupancyMaxActiveBlocksPerMultiprocessor(&per_cu, (const void*)fwd_kernel, NTHR, LDS_BYTES);
        if (per_cu < 1) { fprintf(stderr, "kernel_launch: occupancy query says %d blocks per CU\n", per_cu); per_cu = 1; }
        (void)hipGetLastError();
        grid = cus * 1;
    }
    if (grid < 0) return;
    Params p{};
    for (int i = 0; i < 27; ++i) p.in[i] = (const float*)d_in[i];
    p.out = (float*)d_out; p.ws = (unsigned char*)d_ws;
#if defined(MULTI_LAUNCH)
    for (int k = 0; k < 11; ++k) { int lo = k, hi = k + 1; hipLaunchKernelGGL(fwd_kernel, dim3(grid), dim3(NTHR), LDS_BYTES, stream, p, lo, hi); }
#else
    int lo = PH_LO, hi = PH_HI;
    void* args[] = {&p, &lo, &hi};
    hipError_t e = hipLaunchCooperativeKernel((const void*)fwd_kernel, dim3(grid), dim3(NTHR), args, LDS_BYTES, stream);
    if (e != hipSuccess) fprintf(stderr, "cooperative launch failed: %s (grid %d)\n", hipGetErrorString(e), grid);
#endif
}
```

```cpp
#include <hip/hip_runtime.h>
#include <hip/hip_cooperative_groups.h>
#include <cstdio>
namespace cg = cooperative_groups;

#define DI __device__ __forceinline__
#define LAS __attribute__((address_space(3)))
#define PG8_LAS __attribute__((address_space(3)))
typedef unsigned short bf16_t;
typedef short bf16x8 __attribute__((ext_vector_type(8)));
typedef short s16x4 __attribute__((ext_vector_type(4)));
typedef float f32x4 __attribute__((ext_vector_type(4)));
typedef float f32x16 __attribute__((ext_vector_type(16)));
typedef unsigned u32x4 __attribute__((ext_vector_type(4)));
typedef unsigned u32x2 __attribute__((ext_vector_type(2)));

constexpr int NB = 8, SEQ = 4096, DM = 1024, MTOK = NB * SEQ, CTXL = 256, MCTX = NB * CTXL;
constexpr int DIN = 3584, DFF = 2816, NH = 4, DHD = 128, NMOD = 6;
constexpr float EPSF = 1e-6f;
constexpr int NTHR = 512;
constexpr int LDS_BYTES = 160 * 1024;

constexpr size_t WS_WIN = 0;
constexpr size_t WS_WOUT = WS_WIN + (size_t)DIN * DM * 2;
constexpr size_t WS_WGU = WS_WOUT + (size_t)DM * DM * 2;
constexpr size_t WS_WDN = WS_WGU + (size_t)2 * DFF * DM * 2;
constexpr size_t WS_MOD = WS_WDN + (size_t)DM * DFF * 2;
constexpr size_t WS_ROPE = WS_MOD + (size_t)9 * 6144 * 4;
constexpr size_t WS_FH3 = WS_ROPE + (size_t)SEQ * 64 * 2 * 4;
constexpr size_t WS_KERN = WS_FH3 + (size_t)SEQ * 64 * 4;
constexpr size_t WS_KSUM = WS_KERN + (size_t)2 * 512 * SEQ * 4;
constexpr size_t WS_MISC = WS_KSUM + 2048;
constexpr size_t WS_BAR = WS_MISC + 4096 + 2048;
constexpr size_t WS_KVC = WS_BAR + 16384;
constexpr size_t WS_HA = WS_KVC + (size_t)MCTX * 1024 * 2;
constexpr size_t WS_P = WS_HA + (size_t)(MTOK + MCTX) * DM * 2;
constexpr size_t WS_ST = WS_P + (size_t)MTOK * DIN * 2;
constexpr size_t WS_U = WS_ST + (size_t)2 * 32 * 32 * 16384 * 2;
constexpr size_t WS_YC = WS_U + (size_t)512 * NB * SEQ * 2;
constexpr size_t WS_END = WS_YC + (size_t)512 * NB * SEQ * 2;
constexpr size_t WS_MIXIN = WS_HA, WS_H2 = WS_HA, WS_ACT = WS_P;
constexpr size_t WS_MG = WS_ST, WS_FG = WS_HA;

struct Params { const float* in[27]; float* out; unsigned char* ws; };

DI unsigned short f2bf(float f) { unsigned u = __float_as_uint(f); u += 0x7FFFu + ((u >> 16) & 1u); return (unsigned short)(u >> 16); }
DI float bf2f(unsigned short b) { return __uint_as_float(((unsigned)b) << 16); }
typedef __bf16 bf16x2_t __attribute__((ext_vector_type(2)));
typedef float f32x2_t __attribute__((ext_vector_type(2)));
DI unsigned pk2(float lo, float hi) { const f32x2_t v = {lo, hi}; const bf16x2_t r = __builtin_convertvector(v, bf16x2_t); return __builtin_bit_cast(unsigned, r); }
DI float bflo(unsigned w) { return __uint_as_float(w << 16); }
DI float bfhi(unsigned w) { return __uint_as_float(w & 0xffff0000u); }
DI float wave_sum(float v) {
#pragma unroll
    for (int o = 32; o > 0; o >>= 1) v += __shfl_xor(v, o);
    return v;
}
DI float sigmoidf_(float x) { return __builtin_amdgcn_rcpf(1.0f + __builtin_amdgcn_exp2f(-1.4426950408889634f * x)); }
#define MFMA16(a, b, c) __builtin_amdgcn_mfma_f32_16x16x32_bf16((a), (b), (c), 0, 0, 0)
#define MFMA32(a, b, c) __builtin_amdgcn_mfma_f32_32x32x16_bf16((a), (b), (c), 0, 0, 0)

DI bf16x8 tr_read8(const LAS unsigned char* p, int hi_off) {
    const s16x4 lo = __builtin_amdgcn_ds_read_tr16_b64_v4i16((LAS s16x4*)p);
    const s16x4 hi = __builtin_amdgcn_ds_read_tr16_b64_v4i16((LAS s16x4*)(p + hi_off));
    return __builtin_shufflevector(lo, hi, 0, 1, 2, 3, 4, 5, 6, 7);
}
DI void lds_barrier() { asm volatile("s_waitcnt lgkmcnt(0)" ::: "memory"); __builtin_amdgcn_s_barrier(); asm volatile("" ::: "memory"); }
namespace pg8 {
constexpr int BM = 256, BK = 64, HALF = 128, HTB = HALF * BK * 2  , STAGE_BYTES = 8 * HTB, NXCD = 8, WGM = 1;

__host__ __device__ __forceinline__ int lds_byte(int r, int c) { const int st = (r >> 4) * 2 + (c >> 5), rr = r & 15, cc = c & 31, ob = rr * 64 + cc * 2; return st * 1024 + (ob ^ (((ob >> 9) & 1) << 5)); }
__host__ __device__ __forceinline__ void stage_rc(int b, int& R, int& C) { const int st = b / 1024, sb = b % 1024, swz = sb ^ (((sb >> 9) & 1) << 5); R = (st >> 1) * 16 + swz / 64; C = (st & 1) * 32 + (swz % 64) / 2; }
__host__ __device__ __forceinline__ int perm32(int rho) { const int n = rho >> 4, i = rho & 15; return 8 * (i >> 2) + 4 * n + (i & 3); }

struct Unit { int pm, pn; };
struct Gemm { const bf16_t* A; const bf16_t* Bt; int M, N, K; };

struct StaticOrder {
    int nM, nN, nwg, G, c;
    __host__ __device__ void init(int M, int N, int G_, int c_) { nM = M / BM; nN = N / BM; nwg = nM * nN; G = G_; c = c_; }
    __host__ __device__ bool next(int i, Unit& u) const {
        const long L = (long)i * G + c; if (L >= nwg) return false;
        int wgid = (int)L; { const int q = nwg / NXCD, r = nwg % NXCD, xcd = wgid % NXCD, off = wgid / NXCD; wgid = (xcd < r ? xcd * (q + 1) : r * (q + 1) + (xcd - r) * q) + off; }
        const int nig = WGM * nN, gid = wgid / nig, fm = gid * WGM, gsz = (nM - fm) < WGM ? (nM - fm) : WGM;
        u.pm = fm + ((wgid % nig) % gsz); u.pn = (wgid % nig) / gsz; return true;
    }
    __device__ __forceinline__ void a_ready(const Unit&) const {}
    __device__ __forceinline__ void done(const Unit&) const {}
};

struct EpiP {
    static constexpr bool PERM = true, AFTER_DRAIN = false;
    bf16_t* P; const float* rope;
    __device__ __forceinline__ void operator()(const f32x4 (&acc)[2][2][4][2], const Unit& u, int wr, int wc, int fr, int fq) const {
        const int row0 = u.pm * BM + wr * 64 + fr, col0 = u.pn * BM + wc * 32 + 8 * fq;
        const int mode = u.pn < 2 ? 1 : (u.pn < 4 ? 2 : 0);
        const float sc = mode == 2 ? 0.08838834764831845f : 1.0f;
        const int mp = 16 * wc + 4 * fq;
#pragma unroll
        for (int ai = 0; ai < 2; ++ai) {
          f32x4 rr0[4], rr1[4];
#pragma unroll
          for (int m = 0; m < 4; ++m) { rr0[m] = (f32x4){1.f, 0.f, 1.f, 0.f}; rr1[m] = rr0[m];
              if (mode) { const float* rp = rope + ((size_t)((row0 + ai * HALF + m * 16) & (SEQ - 1)) * 64 + mp) * 2; rr0[m] = *(const f32x4*)rp; rr1[m] = *(const f32x4*)(rp + 4); } }
          asm volatile("" ::: "memory");
#pragma unroll
            for (int m = 0; m < 4; ++m) {
                const int row = row0 + ai * HALF + m * 16;
                bf16_t* rowp = P + (size_t)row * DIN + col0;
                const f32x4 r0 = rr0[m], r1 = rr1[m];
#pragma unroll
                for (int bj = 0; bj < 2; ++bj) {
                    f32x4 v0 = acc[ai][bj][m][0], v1 = acc[ai][bj][m][1];
                    if (mode) {
                        f32x4 a, b;
                        a[0] = v0[0] * r0[0] - v0[1] * r0[1]; a[1] = v0[0] * r0[1] + v0[1] * r0[0];
                        a[2] = v0[2] * r0[2] - v0[3] * r0[3]; a[3] = v0[2] * r0[3] + v0[3] * r0[2];
                        b[0] = v1[0] * r1[0] - v1[1] * r1[1]; b[1] = v1[0] * r1[1] + v1[1] * r1[0];
                        b[2] = v1[2] * r1[2] - v1[3] * r1[3]; b[3] = v1[2] * r1[3] + v1[3] * r1[2];
                        v0 = a * sc; v1 = b * sc;
                    }
                    u32x4 w; w.x = pk2(v0[0], v0[1]); w.y = pk2(v0[2], v0[3]); w.z = pk2(v1[0], v1[1]); w.w = pk2(v1[2], v1[3]);
                    *(u32x4*)(rowp + bj * HALF) = w;
                }
            }
          asm volatile("" ::: "memory");
        }
    }
};
struct EpiKV {
    static constexpr bool PERM = true, AFTER_DRAIN = false;
    bf16_t* O;
    __device__ __forceinline__ void operator()(const f32x4 (&acc)[2][2][4][2], const Unit& u, int wr, int wc, int fr, int fq) const {
        const int row0 = u.pm * BM + wr * 64 + fr, col0 = u.pn * BM + wc * 32 + 8 * fq;
        const float sc = u.pn < 2 ? 0.08838834764831845f : 1.0f;
#pragma unroll
        for (int ai = 0; ai < 2; ++ai)
#pragma unroll
            for (int m = 0; m < 4; ++m) {
                bf16_t* rowp = O + (size_t)(row0 + ai * HALF + m * 16) * 1024 + col0;
#pragma unroll
                for (int bj = 0; bj < 2; ++bj) {
                    const f32x4 v0 = acc[ai][bj][m][0] * sc, v1 = acc[ai][bj][m][1] * sc;
                    u32x4 w; w.x = pk2(v0[0], v0[1]); w.y = pk2(v0[2], v0[3]); w.z = pk2(v1[0], v1[1]); w.w = pk2(v1[2], v1[3]);
                    *(u32x4*)(rowp + bj * HALF) = w;
                }
            }
    }
};
struct EpiRes {
    static constexpr bool PERM = false, AFTER_DRAIN = false;
    const float* resid; float* out; const float* gate;
    __device__ __forceinline__ void operator()(const f32x4 (&acc)[2][2][4][2], const Unit& u, int wr, int wc, int fr, int fq) const {
        const int row0 = u.pm * BM + wr * 64 + fr, col0 = u.pn * BM + wc * 32 + 4 * fq;
        const int b = (u.pm * BM) >> 12;
        f32x4 gv[2][2];
#pragma unroll
        for (int bj = 0; bj < 2; ++bj)
#pragma unroll
            for (int n = 0; n < 2; ++n) gv[bj][n] = *(const f32x4*)(gate + (size_t)b * 6144 + col0 + bj * HALF + n * 16);
#pragma unroll
        for (int ai = 0; ai < 2; ++ai) {
            f32x4 r[4][2][2];
#pragma unroll
            for (int m = 0; m < 4; ++m)
#pragma unroll
                for (int bj = 0; bj < 2; ++bj)
#pragma unroll
                    for (int n = 0; n < 2; ++n) r[m][bj][n] = *(const f32x4*)(resid + (size_t)(row0 + ai * HALF + m * 16) * DM + col0 + bj * HALF + n * 16);
            asm volatile("" ::: "memory");
#pragma unroll
            for (int m = 0; m < 4; ++m)
#pragma unroll
                for (int bj = 0; bj < 2; ++bj)
#pragma unroll
                    for (int n = 0; n < 2; ++n) *(f32x4*)(out + (size_t)(row0 + ai * HALF + m * 16) * DM + col0 + bj * HALF + n * 16) = r[m][bj][n] + gv[bj][n] * acc[ai][bj][m][n];
            asm volatile("" ::: "memory");
        }
    }
};
struct EpiSwiGLU {
    static constexpr bool PERM = true, AFTER_DRAIN = false;
    bf16_t* O;
    __device__ __forceinline__ void operator()(const f32x4 (&acc)[2][2][4][2], const Unit& u, int wr, int wc, int fr, int fq) const {
        const int row0 = u.pm * BM + wr * 64 + fr, col0 = u.pn * HALF + wc * 32 + 8 * fq;
#pragma unroll
        for (int ai = 0; ai < 2; ++ai)
#pragma unroll
            for (int m = 0; m < 4; ++m) {
                bf16_t* rowp = O + (size_t)(row0 + ai * HALF + m * 16) * DFF + col0;
                const f32x4 g0 = acc[ai][0][m][0], g1 = acc[ai][0][m][1];
                const f32x4 t0 = g0 * -1.4426950408889634f, t1 = g1 * -1.4426950408889634f;
                f32x4 e0, e1;
#pragma unroll
                for (int j = 0; j < 4; ++j) { e0[j] = __builtin_amdgcn_exp2f(t0[j]); e1[j] = __builtin_amdgcn_exp2f(t1[j]); }
                const f32x4 d0 = e0 + 1.0f, d1 = e1 + 1.0f;
                f32x4 r0, r1;
#pragma unroll
                for (int j = 0; j < 4; ++j) { r0[j] = __builtin_amdgcn_rcpf(d0[j]); r1[j] = __builtin_amdgcn_rcpf(d1[j]); }
                const f32x4 v0 = (g0 * acc[ai][1][m][0]) * r0, v1 = (g1 * acc[ai][1][m][1]) * r1;
                u32x4 w; w.x = pk2(v0[0], v0[1]); w.y = pk2(v0[2], v0[3]); w.z = pk2(v1[0], v1[1]); w.w = pk2(v1[2], v1[3]);
                *(u32x4*)rowp = w;
            }
    }
};

struct EpiGateBf {
    static constexpr bool PERM = true, AFTER_DRAIN = false;
    bf16_t* O; const float* gate;
    __device__ __forceinline__ void operator()(const f32x4 (&acc)[2][2][4][2], const Unit& u, int wr, int wc, int fr, int fq) const {
        const int row0 = u.pm * BM + wr * 64 + fr, col0 = u.pn * BM + wc * 32 + 8 * fq;
        const int b = (u.pm * BM) >> 12;
        f32x4 gv[2][2];
#pragma unroll
        for (int bj = 0; bj < 2; ++bj)
#pragma unroll
            for (int n = 0; n < 2; ++n) gv[bj][n] = *(const f32x4*)(gate + (size_t)b * 6144 + col0 + bj * HALF + 4 * n);
#pragma unroll
        for (int ai = 0; ai < 2; ++ai)
#pragma unroll
            for (int m = 0; m < 4; ++m) {
                bf16_t* rowp = O + (size_t)(row0 + ai * HALF + m * 16) * DM + col0;
#pragma unroll
                for (int bj = 0; bj < 2; ++bj) {
                    const f32x4 v0 = acc[ai][bj][m][0] * gv[bj][0], v1 = acc[ai][bj][m][1] * gv[bj][1];
                    u32x4 w; w.x = pk2(v0[0], v0[1]); w.y = pk2(v0[2], v0[3]); w.z = pk2(v1[0], v1[1]); w.w = pk2(v1[2], v1[3]);
                    *(u32x4*)(rowp + bj * HALF) = w;
                }
            }
    }
};
template <class Epi, class Sched>
__device__ __forceinline__ void gemm_phase(PG8_LAS unsigned char* lds, const Gemm g, const Sched& S, const Epi& E) {
    const int tid = threadIdx.x, wid = __builtin_amdgcn_readfirstlane(tid >> 6), lane = tid & 63, wr = wid >> 2, wc = wid & 3, fr = lane & 15, fq = lane >> 4;
    const int K = g.K, nt = K / BK;
    unsigned voffA[2], voffB[2];
#pragma unroll
    for (int i = 0; i < 2; ++i) { int R, C; stage_rc(tid * 16 + i * 8192, R, C); const int Rb = Epi::PERM ? ((R & ~31) + perm32(R & 31)) : R;
        voffA[i] = (unsigned)(R * K + C) * 2u; voffB[i] = (unsigned)(Rb * K + C) * 2u; }
    const size_t kstep = (size_t)(BK * 2);
    const size_t hstep = (size_t)HALF * K * 2;
    const size_t tstep = 2 * hstep;
    const unsigned ldsw = (unsigned)wid * 1024u;
    const int aoff = lds_byte(wr * 64 + fr, fq * 8), boff = lds_byte(wc * 32 + fr, fq * 8);
#define PG8_SA(b, h) (((b) * 2 + (h)) * HTB)
#define PG8_SB(b, h) ((4 + (b) * 2 + (h)) * HTB)
#define PG8_STAGE(bufoff, gbase, voff) do { _Pragma("unroll") for (int _i = 0; _i < 2; ++_i) \
        __builtin_amdgcn_global_load_lds((const unsigned*)((const char*)(gbase) + (voff)[_i]), (PG8_LAS unsigned*)(lds + (bufoff) + ldsw + _i * 8192), 16, 0, 0); } while (0)
#define PG8_LDA(dst, b, h) do { _Pragma("unroll") for (int m = 0; m < 4; ++m) _Pragma("unroll") for (int k = 0; k < 2; ++k) dst[m][k] = *(const PG8_LAS bf16x8*)(lds + PG8_SA(b, h) + aoff + m * 2048 + k * 1024); } while (0)
#define PG8_LDB(dst, b, h) do { _Pragma("unroll") for (int n = 0; n < 2; ++n) _Pragma("unroll") for (int k = 0; k < 2; ++k) dst[n][k] = *(const PG8_LAS bf16x8*)(lds + PG8_SB(b, h) + boff + n * 2048 + k * 1024); } while (0)
#define PG8_MMA(ai, bj, At, Bt) do { __builtin_amdgcn_s_setprio(1); _Pragma("unroll") for (int m = 0; m < 4; ++m) _Pragma("unroll") for (int n = 0; n < 2; ++n) _Pragma("unroll") for (int k = 0; k < 2; ++k) \
        acc[ai][bj][m][n] = __builtin_amdgcn_mfma_f32_16x16x32_bf16(Bt[n][k], At[m][k], acc[ai][bj][m][n], 0, 0, 0); __builtin_amdgcn_s_setprio(0); } while (0)
#define PG8_WAIT_V(n) asm volatile("s_waitcnt vmcnt(" #n ")" ::: "memory")
#define PG8_WAIT_L(n) asm volatile("s_waitcnt lgkmcnt(" #n ")" ::: "memory")
#define PG8_BAR __builtin_amdgcn_s_barrier()
#define PG8_SCHED __builtin_amdgcn_sched_barrier(0)
    Unit cur, nxt; int ui = 0;
    if (!S.next(0, cur)) return;
    f32x4 acc[2][2][4][2];
#pragma unroll
    for (int a = 0; a < 2; ++a)
#pragma unroll
        for (int b = 0; b < 2; ++b)
#pragma unroll
            for (int m = 0; m < 4; ++m)
#pragma unroll
                for (int n = 0; n < 2; ++n) acc[a][b][m][n] = (f32x4){0.f, 0.f, 0.f, 0.f};
    bf16x8 At[4][2], B0[2][2], B1[2][2];
    const char* cA = (const char*)g.A + (size_t)cur.pm * tstep; const char* cB = (const char*)g.Bt + (size_t)cur.pn * tstep;
    S.a_ready(cur);
    PG8_STAGE(PG8_SB(0, 0), cB, voffB); PG8_STAGE(PG8_SA(0, 0), cA, voffA); PG8_STAGE(PG8_SB(0, 1), cB + hstep, voffB); PG8_STAGE(PG8_SA(0, 1), cA + hstep, voffA);
    if (wr == 1) PG8_BAR;
    PG8_WAIT_V(4); PG8_BAR;
    PG8_STAGE(PG8_SB(1, 0), cB + kstep, voffB); PG8_STAGE(PG8_SA(1, 0), cA + kstep, voffA); PG8_STAGE(PG8_SB(1, 1), cB + hstep + kstep, voffB);
    PG8_WAIT_V(6); PG8_BAR;
    for (;;) {
        const bool has_next = S.next(ui + 1, nxt);
        const char* nA = has_next ? (const char*)g.A + (size_t)nxt.pm * tstep : cA; const char* nB = has_next ? (const char*)g.Bt + (size_t)nxt.pn * tstep : cB;
        for (int t = 0; t < nt; t += 2) {
            const bool last = (t == nt - 2);
            const char* a1 = cA + (size_t)(t + 1) * kstep;
            const char* a2 = last ? nA : cA + (size_t)(t + 2) * kstep; const char* b2 = last ? nB : cB + (size_t)(t + 2) * kstep;
            const char* a3 = a2 + kstep; const char* b3 = b2 + kstep;
            if (last && has_next) S.a_ready(nxt);
            PG8_LDB(B0, 0, 0); PG8_SCHED; PG8_LDA(At, 0, 0); PG8_STAGE(PG8_SA(1, 1), a1 + hstep, voffA);
            PG8_WAIT_L(8); PG8_BAR; PG8_WAIT_L(0); PG8_MMA(0, 0, At, B0); PG8_BAR; PG8_SCHED;
            PG8_LDB(B1, 0, 1); PG8_STAGE(PG8_SB(0, 0), b2, voffB);
            PG8_BAR; PG8_WAIT_L(0); PG8_MMA(0, 1, At, B1); PG8_BAR;
            PG8_LDA(At, 0, 1); PG8_STAGE(PG8_SA(0, 0), a2, voffA);
            PG8_BAR; PG8_WAIT_L(0); PG8_MMA(1, 0, At, B0); PG8_BAR; PG8_SCHED;
            PG8_STAGE(PG8_SB(0, 1), b2 + hstep, voffB);
            PG8_WAIT_V(6); PG8_BAR; PG8_MMA(1, 1, At, B1); PG8_BAR;
            PG8_LDB(B0, 1, 0); PG8_SCHED; PG8_LDA(At, 1, 0); PG8_STAGE(PG8_SA(0, 1), a2 + hstep, voffA);
            PG8_WAIT_L(8); PG8_BAR; PG8_WAIT_L(0); PG8_MMA(0, 0, At, B0); PG8_BAR; PG8_SCHED;
            PG8_LDB(B1, 1, 1); PG8_STAGE(PG8_SB(1, 0), b3, voffB);
            PG8_BAR; PG8_WAIT_L(0); PG8_MMA(0, 1, At, B1); PG8_BAR;
            PG8_LDA(At, 1, 1); PG8_STAGE(PG8_SA(1, 0), a3, voffA);
            PG8_BAR; PG8_WAIT_L(0); PG8_MMA(1, 0, At, B0); PG8_BAR; PG8_SCHED;
            PG8_STAGE(PG8_SB(1, 1), b3 + hstep, voffB);
            PG8_WAIT_V(6); PG8_BAR; PG8_MMA(1, 1, At, B1); PG8_BAR;
        }
        if constexpr (!Epi::AFTER_DRAIN) { E(acc, cur, wr, wc, fr, fq); S.done(cur); }
        if (!has_next) break;
#pragma unroll
        for (int a = 0; a < 2; ++a)
#pragma unroll
            for (int b = 0; b < 2; ++b)
#pragma unroll
                for (int m = 0; m < 4; ++m)
#pragma unroll
                    for (int n = 0; n < 2; ++n) acc[a][b][m][n] = (f32x4){0.f, 0.f, 0.f, 0.f};
        cur = nxt; cA = nA; cB = nB; ++ui;
    }
    PG8_WAIT_V(0);
    if (wr == 0) PG8_BAR;
    PG8_BAR;
    if constexpr (Epi::AFTER_DRAIN) { E.fused(acc, cur, wr, wc, fr, fq, lds, wid, lane); S.done(cur); }
#undef PG8_SA
#undef PG8_SB
#undef PG8_STAGE
#undef PG8_LDA
#undef PG8_LDB
#undef PG8_MMA
#undef PG8_WAIT_V
#undef PG8_WAIT_L
#undef PG8_BAR
#undef PG8_SCHED
}
}
#define XB_TMO      128
#define XB_XCNT(j)  (256  + 64 * (j))
#define XB_XSUB(j)  (1280 + 64 * (j))
#define XB_XGEN(j)  (2304 + 64 * (j))
#define XB_TOP      3328
#define XB_TOPGEN   3392
#define XCD_BAR_WORDS 3456
#define XB_SPIN_CAP (1u << 18)

__device__ __forceinline__ unsigned xb_ld(unsigned* p)              { return __hip_atomic_load(p, __ATOMIC_RELAXED, __HIP_MEMORY_SCOPE_AGENT); }
__device__ __forceinline__ unsigned xb_add(unsigned* p, unsigned v) { return __hip_atomic_fetch_add(p, v, __ATOMIC_RELAXED, __HIP_MEMORY_SCOPE_AGENT); }
__device__ __forceinline__ unsigned xb_xcc_id() { return (unsigned)__builtin_amdgcn_s_getreg((3 << 11) | 20) & 0xFu; }
#define XB_SPIN(cond, bar) do { unsigned _sp = 0; while (cond) { __builtin_amdgcn_s_sleep(1); \
    if ((++_sp & 255u) == 0u) { if (xb_ld(&(bar)[XB_TMO])) break; if (_sp > XB_SPIN_CAP) { atomicAdd(&(bar)[XB_TMO], 1u); break; } } } } while (0)

struct XcdBarrier {
    unsigned* bar; unsigned x;
    volatile LAS unsigned* st;
};

__device__ __forceinline__ XcdBarrier xcd_barrier_post(unsigned* bar, volatile LAS unsigned* st) {
    XcdBarrier b; b.bar = bar; b.x = xb_xcc_id(); b.st = st;
    if (threadIdx.x == 0) (void)xb_add(&bar[XB_XCNT(b.x)], 1u);
    return b;
}
__device__ __forceinline__ void xcd_barrier_complete(unsigned* bar, unsigned x, unsigned& nloc, unsigned& nx) {
    const unsigned G = gridDim.x * gridDim.y * gridDim.z;
    unsigned sum, cnt, mine, sp = 0u;
    for (;;) {
        sum = 0u; cnt = 0u; mine = 0u;
#pragma unroll
        for (unsigned j = 0; j < 16; ++j) { const unsigned c = xb_ld(&bar[XB_XCNT(j)]); sum += c; cnt += (c > 0u) ? 1u : 0u; mine = (j == x) ? c : mine; }
        if (sum == G) break;
        __builtin_amdgcn_s_sleep(1);
        if ((++sp & 255u) == 0u) { if (xb_ld(&bar[XB_TMO])) break; if (sp > XB_SPIN_CAP) { atomicAdd(&bar[XB_TMO], 1u); break; } }
    }
    nloc = mine > 0u ? mine : 1u; nx = cnt > 0u ? cnt : 1u;
}

__device__ __forceinline__ void xcd_barrier(const XcdBarrier& b) {
    asm volatile("s_waitcnt vmcnt(0)" ::: "memory");
    __syncthreads();
    if (threadIdx.x == 0) {
        unsigned* bar = b.bar;
        __builtin_amdgcn_s_waitcnt(0);
        unsigned nloc = b.st[0], nx = b.st[1];
        if (nloc == 0u) { xcd_barrier_complete(bar, b.x, nloc, nx); b.st[0] = nloc; b.st[1] = nx; }
        const unsigned old = xb_add(&bar[XB_XSUB(b.x)], 1u);
        const unsigned gen = old / nloc;
        if (old + 1u == (gen + 1u) * nloc) {
            __builtin_amdgcn_fence(__ATOMIC_RELEASE, "agent");
            asm volatile("s_waitcnt vmcnt(0)" ::: "memory");
            const unsigned og = xb_add(&bar[XB_TOP], 1u);
            const unsigned tg = og / nx;
            if (og + 1u == (tg + 1u) * nx) xb_add(&bar[XB_TOPGEN], 1u);
            else XB_SPIN(xb_ld(&bar[XB_TOPGEN]) == tg, bar);
            __builtin_amdgcn_fence(__ATOMIC_ACQUIRE, "agent");
            xb_add(&bar[XB_XGEN(b.x)], 1u);
            asm volatile("s_waitcnt vmcnt(0)" ::: "memory");
        } else {
            XB_SPIN(xb_ld(&bar[XB_XGEN(b.x)]) == gen, bar);
            __builtin_amdgcn_fence(__ATOMIC_ACQUIRE, "agent");
            asm volatile("s_waitcnt vmcnt(0)" ::: "memory");
        }
    }
    __syncthreads();
}

DI int src_col(int kind, int n) {
    if (kind == 0) { if (n < 1024) { const int hh = n >> 7, ch = n & 127; return hh * 128 + (ch >> 1) + 64 * (ch & 1); } return n; }
    if (kind == 2) { const int pn = n >> 8, bj = (n >> 7) & 1, i = n & 127; return bj * DFF + 128 * pn + i; }
    return n;
}
struct TrTile { const float* W; bf16_t* Wt; int K, N, kind, n0, k0; };
DI TrTile tr_decode(const Params& p, int i) {
    TrTile t; int tile;
    if (i < (DIN / 64) * (DM / 64)) { t.W = p.in[8]; t.Wt = (bf16_t*)(p.ws + WS_WIN); t.K = DM; t.N = DIN; t.kind = 0; tile = i; }
    else if ((i -= (DIN / 64) * (DM / 64)) < (DM / 64) * (DM / 64)) { t.W = p.in[23]; t.Wt = (bf16_t*)(p.ws + WS_WOUT); t.K = DM; t.N = DM; t.kind = 1; tile = i; }
    else if ((i -= (DM / 64) * (DM / 64)) < (2 * DFF / 64) * (DM / 64)) { t.W = p.in[24]; t.Wt = (bf16_t*)(p.ws + WS_WGU); t.K = DM; t.N = 2 * DFF; t.kind = 2; tile = i; }
    else { i -= (2 * DFF / 64) * (DM / 64); t.W = p.in[25]; t.Wt = (bf16_t*)(p.ws + WS_WDN); t.K = DFF; t.N = DM; t.kind = 3; tile = i; }
    const int ntk = t.K / 64; t.n0 = (tile / ntk) * 64; t.k0 = (tile % ntk) * 64;
    return t;
}
DI void transpose_tiles(unsigned char* lds, const Params& p, int i0, int stride, int n_tiles) {
    const int tid = threadIdx.x;
    float v[8];
#define TR_LOAD(T) do { _Pragma("unroll") for (int e = 0; e < 8; ++e) { const int idx = tid + NTHR * e, kk = idx >> 6, nn = idx & 63; v[e] = (T).W[(size_t)((T).k0 + kk) * (T).N + src_col((T).kind, (T).n0 + nn)]; } } while (0)
    if (i0 >= n_tiles) return;
    TrTile cur = tr_decode(p, i0);
    TR_LOAD(cur);
    int par = 0;
    for (int i = i0; i < n_tiles; i += stride, par ^= 1) {
        bf16_t* T = (bf16_t*)lds + par * (64 * 72);
#pragma unroll
        for (int e = 0; e < 8; ++e) { const int idx = tid + NTHR * e, kk = idx >> 6, nn = idx & 63; T[nn * 72 + kk] = f2bf(v[e]); }
        const TrTile done = cur;
        if (i + stride < n_tiles) { cur = tr_decode(p, i + stride); TR_LOAD(cur); }
        lds_barrier();
        { const int nn = tid >> 3, seg = tid & 7; *(u32x4*)(done.Wt + (size_t)(done.n0 + nn) * done.K + done.k0 + 8 * seg) = *(const u32x4*)(T + nn * 72 + 8 * seg); }
    }
    lds_barrier();
#undef TR_LOAD
}
DI void mod_item(unsigned char* lds, const Params& p, int item) {
    float* S = (float*)lds;
    float* R = S + 9 * 1024;
    const int tid = threadIdx.x;
    for (int i = tid; i < 9 * 1024; i += NTHR) { const float v = i < 8192 ? p.in[1][i] : p.in[3][i - 8192]; S[i] = v / (1.0f + __expf(-v)); }
    __syncthreads();
    const int nn = tid & 63, ks = tid >> 6, n = item * 64 + nn;
    float acc[9];
#pragma unroll
    for (int r = 0; r < 9; ++r) acc[r] = 0.f;
    const float* wm = p.in[4] + n;
#pragma unroll 4
    for (int kk = 0; kk < 128; kk += 4) {
        const int k = ks * 128 + kk;
        const float w0 = wm[(size_t)k * 6144], w1 = wm[(size_t)(k + 1) * 6144], w2 = wm[(size_t)(k + 2) * 6144], w3 = wm[(size_t)(k + 3) * 6144];
#pragma unroll
        for (int r = 0; r < 9; ++r) { const f32x4 sv = *(const f32x4*)(S + r * 1024 + k); acc[r] += sv[0] * w0 + sv[1] * w1 + sv[2] * w2 + sv[3] * w3; }
    }
#pragma unroll
    for (int r = 0; r < 9; ++r) R[(ks * 9 + r) * 64 + nn] = acc[r];
    __syncthreads();
    for (int i = tid; i < 9 * 64; i += NTHR) {
        const int r = i >> 6, c = i & 63; float s = p.in[5][item * 64 + c];
#pragma unroll
        for (int k2 = 0; k2 < 8; ++k2) s += R[(k2 * 9 + r) * 64 + c];
        ((float*)(p.ws + WS_MOD))[r * 6144 + item * 64 + c] = s;
    }
    __syncthreads();
}
DI void filt_item(unsigned char* lds, const Params& p, int item, bool& staged) {
    float* E = (float*)lds;
    float* H1 = E + 8 * 36;
    float* H2 = H1 + 512;
    float* W1 = (float*)(lds + 65536);
    float* W2 = W1 + 33 * 64;
    float* W3 = W2 + 64 * 64;
    const int tid = threadIdx.x, tt = tid >> 6, j = tid & 63, t = item * 8 + tt;
    if (!staged) { staged = true;
        for (int i = tid; i < 33 * 64; i += NTHR) W1[i] = p.in[13][i];
        for (int i = tid; i < 64 * 64; i += NTHR) { W2[i] = p.in[15][i]; W3[i] = p.in[17][i]; } }
    if (j < 33) {
        float v;
        if (j == 0) v = (float)((double)t / 4095.0);
        else {
            const int bi = (j - 1) & 15;
            const double f = (double)(1e-4f) + (double)bi * (((double)15.0f - (double)1e-4f) / 15.0);
            double xr = f * (double)t * (1.0 / 4096.0); xr -= floor(xr);
            const float ang = 6.283185307179586f * (float)xr;
            v = j <= 16 ? cosf(ang) : -sinf(ang);
        }
        E[tt * 36 + j] = v;
    }
    __syncthreads();
    const float fr = p.in[20][j];
    { float a = p.in[14][j];
#pragma unroll
      for (int i = 0; i < 33; ++i) a += E[tt * 36 + i] * W1[i * 64 + j];
      H1[tt * 64 + j] = sinf(fr * a); }
    __syncthreads();
    { float a = p.in[16][j];
#pragma unroll 16
      for (int i = 0; i < 64; ++i) a += H1[tt * 64 + i] * W2[i * 64 + j];
      H2[tt * 64 + j] = sinf(fr * a); }
    __syncthreads();
    { float a = p.in[18][j];
#pragma unroll 16
      for (int i = 0; i < 64; ++i) a += H2[tt * 64 + i] * W3[i * 64 + j];
      ((float*)(p.ws + WS_FH3))[(size_t)t * 64 + j] = sinf(fr * a); }
    __syncthreads();
}
constexpr int T_WIN = (DIN / 64) * (DM / 64), T_WOUT = (DM / 64) * (DM / 64), T_WGU = (2 * DFF / 64) * (DM / 64), T_WDN = (DM / 64) * (DFF / 64);
DI void phase0(unsigned char* lds, const Params& p) {
    const int tid = threadIdx.x;
    { float* rope = (float*)(p.ws + WS_ROPE);
      for (int idx = blockIdx.x * NTHR + tid; idx < SEQ * 64; idx += gridDim.x * NTHR) {
          const int t = idx >> 6, m = idx & 63, row = t >> 6, col = t & 63;
          const float inv = powf(10000.0f, -(float)(m & 31) / 32.0f);
          const float ang = (float)(m < 32 ? row : col) * inv;
          rope[2 * idx] = cosf(ang); rope[2 * idx + 1] = sinf(ang);
      }
      if (blockIdx.x == 0) { for (int i = tid; i < 512 + 1024; i += NTHR) ((float*)(p.ws + WS_KSUM))[i] = 0.f; } }
    bool fw_staged = false;
    if (gridDim.x >= 192) {
        if (blockIdx.x < 96) mod_item(lds, p, blockIdx.x);
        else { const int blk = blockIdx.x - 96, nblk = gridDim.x - 96;
            for (int it = blk; it < 512; it += nblk) filt_item(lds, p, it, fw_staged);
            transpose_tiles(lds, p, blk, nblk, T_WIN); }
        return;
    }
    for (int it = blockIdx.x; it < 96 + 512; it += gridDim.x) {
        if (it < 96) mod_item(lds, p, it); else filt_item(lds, p, it - 96, fw_staged);
    }
    transpose_tiles(lds, p, blockIdx.x, gridDim.x, T_WIN);
}

struct NormRow { f32x4 v[4]; u32x2 ad[4]; };
DI void nrow_load(NormRow& R, const float* s, const bf16_t* ad, int lane) {
#pragma unroll
    for (int k = 0; k < 4; ++k) { const int c = 4 * lane + 256 * k; R.v[k] = *(const f32x4*)(s + c); if (ad) R.ad[k] = *(const u32x2*)(ad + c); }
}
DI void norm_rows(const float* src, const bf16_t* addend, float* xsum, bf16_t* dst, int row_lo, int row_hi, const float* gain, const float* mod, int shift_i, int scale_i, int ctx_row, int blk, int nblk) {
    const bool has_ad = addend != nullptr;
    const int lane = threadIdx.x & 63, w = threadIdx.x >> 6, nw = nblk * 8, wid = blk * 8 + w;
    const int per = (row_hi - row_lo + nw - 1) / nw;
    const int r0 = row_lo + wid * per, r1 = (r0 + per < row_hi) ? r0 + per : row_hi;
    if (r0 >= r1) return;
    f32x4 A[4], Bm[4]; int curb = -1;
    NormRow R[4];
#define NR_LOAD(set, row) nrow_load(R[set], src + (size_t)((row) - row_lo) * DM, has_ad ? addend + (size_t)((row) - row_lo) * DM : nullptr, lane)
#define NR_STEP(u, row) do { if ((row) < r1) { \
        if ((row) + 3 < r1) NR_LOAD(((u) + 3) & 3, (row) + 3); \
        const int b_ = ctx_row >= 0 ? ctx_row : ((row) >> 12); \
        if (b_ != curb) { curb = b_; const float* mr_ = mod + (size_t)b_ * 6144; \
            _Pragma("unroll") for (int k = 0; k < 4; ++k) { const int c = 4 * lane + 256 * k; const f32x4 g_ = *(const f32x4*)(gain + c), sc_ = *(const f32x4*)(mr_ + scale_i * 1024 + c); A[k] = g_ * (sc_ + 1.0f); Bm[k] = *(const f32x4*)(mr_ + shift_i * 1024 + c); } } \
        NormRow& Q = R[u]; \
        if (has_ad) { _Pragma("unroll") for (int k = 0; k < 4; ++k) { Q.v[k] += (f32x4){bflo(Q.ad[k].x), bfhi(Q.ad[k].x), bflo(Q.ad[k].y), bfhi(Q.ad[k].y)}; if (xsum) *(f32x4*)(xsum + (size_t)((row) - row_lo) * DM + 4 * lane + 256 * k) = Q.v[k]; } } \
        float ss = 0.f; \
        _Pragma("unroll") for (int k = 0; k < 4; ++k) ss += Q.v[k][0] * Q.v[k][0] + Q.v[k][1] * Q.v[k][1] + Q.v[k][2] * Q.v[k][2] + Q.v[k][3] * Q.v[k][3]; \
        ss = wave_sum(ss); \
        const float rstd = rsqrtf(ss * (1.0f / DM) + EPSF); \
        _Pragma("unroll") for (int k = 0; k < 4; ++k) { const f32x4 h = Q.v[k] * rstd * A[k] + Bm[k]; u32x2 o; o.x = pk2(h[0], h[1]); o.y = pk2(h[2], h[3]); *(u32x2*)(dst + (size_t)(row) * DM + 4 * lane + 256 * k) = o; } \
    } } while (0)
    NR_LOAD(0, r0); if (r0 + 1 < r1) NR_LOAD(1, r0 + 1); if (r0 + 2 < r1) NR_LOAD(2, r0 + 2);
#pragma unroll 1
    for (int r = r0; r < r1; r += 4) { NR_STEP(0, r); NR_STEP(1, r + 1); NR_STEP(2, r + 2); NR_STEP(3, r + 3); }
#undef NR_LOAD
#undef NR_STEP
}
DI void filt4_item(unsigned char* lds, const Params& p, int item) {
    float* F = (float*)lds;
    const int tid = threadIdx.x, tt = item >> 1, dir = item & 1, t0 = tt * 32, c = tid;
    for (int i = tid; i < 32 * 64; i += NTHR) F[i] = ((const float*)(p.ws + WS_FH3))[(size_t)t0 * 64 + i];
    __syncthreads();
    float w4[64];
#pragma unroll
    for (int j = 0; j < 64; ++j) w4[j] = p.in[19][(size_t)j * 1024 + dir * 512 + c];
    const float mind = logf(0.01f) / 1.5f, maxd = logf(0.01f) / 0.3f;
    const float ad = fabsf(mind + (float)c * ((maxd - mind) / 511.0f));
    float* dst = (float*)(p.ws + WS_KERN) + ((size_t)dir * 512 + c) * SEQ + t0;
    float asum = 0.f;
#pragma unroll 1
    for (int q = 0; q < 8; ++q) {
        f32x4 o;
#pragma unroll
        for (int r = 0; r < 4; ++r) {
            const int tl = q * 4 + r; float a = 0.f;
#pragma unroll
            for (int j = 0; j < 64; j += 4) { const f32x4 fv = *(const f32x4*)(F + tl * 64 + j); a += fv[0] * w4[j] + fv[1] * w4[j + 1] + fv[2] * w4[j + 2] + fv[3] * w4[j + 3]; }
            const float tlin = (float)(t0 + tl) / 4095.0f;
            a *= __expf(-tlin * ad);
            o[r] = a;
            if (!(dir == 1 && t0 + tl == 0)) asum += fabsf(a);
        }
        *(f32x4*)(dst + q * 4) = o;
    }
    atomicAdd((float*)(p.ws + WS_KSUM) + c, asum);
    __syncthreads();
}
struct OneUnit { int pm, pn;
    __device__ bool next(int i, pg8::Unit& u) const { if (i) return false; u.pm = pm; u.pn = pn; return true; }
    __device__ __forceinline__ void a_ready(const pg8::Unit&) const {}
    __device__ __forceinline__ void done(const pg8::Unit&) const {} };
DI void phase1(unsigned char* lds, const Params& p) {
    const float* mod = (const float*)(p.ws + WS_MOD);
    bf16_t* HA = (bf16_t*)(p.ws + WS_HA);
    const bool split = gridDim.x >= 64;
    if (split && blockIdx.x < 32) {
        const int pm = blockIdx.x >> 2, pn = blockIdx.x & 3;
        {
          const int lane = threadIdx.x & 63, w = threadIdx.x >> 6;
          const float* src = p.in[2] + ((size_t)pm * 256 + w * 32) * DM; bf16_t* dst = HA + ((size_t)MTOK + pm * 256 + w * 32) * DM;
          f32x4 A[4], Bm[4];
#pragma unroll
          for (int k = 0; k < 4; ++k) { const int c = 4 * lane + 256 * k; const f32x4 g = *(const f32x4*)(p.in[6] + c), sc = *(const f32x4*)(mod + 8 * 6144 + 1024 + c); A[k] = g * (sc + 1.0f); Bm[k] = *(const f32x4*)(mod + 8 * 6144 + c); }
          f32x4 v[4][4];
#pragma unroll
          for (int r = 0; r < 4; ++r)
#pragma unroll
              for (int k = 0; k < 4; ++k) v[r][k] = *(const f32x4*)(src + (size_t)r * DM + 4 * lane + 256 * k);
#pragma unroll 1
          for (int r0 = 0; r0 < 32; r0 += 4) {
#pragma unroll
              for (int r = 0; r < 4; ++r) {
                  float ss = 0.f;
#pragma unroll
                  for (int k = 0; k < 4; ++k) ss += v[r][k][0] * v[r][k][0] + v[r][k][1] * v[r][k][1] + v[r][k][2] * v[r][k][2] + v[r][k][3] * v[r][k][3];
                  ss = wave_sum(ss);
                  const float rstd = rsqrtf(ss * (1.0f / DM) + EPSF);
                  u32x2 o[4];
#pragma unroll
                  for (int k = 0; k < 4; ++k) { const f32x4 h = v[r][k] * rstd * A[k] + Bm[k]; o[k].x = pk2(h[0], h[1]); o[k].y = pk2(h[2], h[3]); }
                  if (r0 + 4 + r < 32) {
#pragma unroll
                      for (int k = 0; k < 4; ++k) v[r][k] = *(const f32x4*)(src + (size_t)(r0 + 4 + r) * DM + 4 * lane + 256 * k);
                  }
#pragma unroll
                  for (int k = 0; k < 4; ++k) *(u32x2*)(dst + (size_t)(r0 + r) * DM + 4 * lane + 256 * k) = o[k];
              }
          } }
        asm volatile("s_waitcnt vmcnt(0)" ::: "memory");
        __builtin_amdgcn_fence(__ATOMIC_RELEASE, "workgroup"); __syncthreads(); __builtin_amdgcn_fence(__ATOMIC_ACQUIRE, "agent");
        asm volatile("s_waitcnt vmcnt(0)" ::: "memory");
        pg8::Gemm g{HA + (size_t)MTOK * DM, (const bf16_t*)(p.ws + WS_WIN) + (size_t)512 * DM, MCTX, 1024, DM};
        OneUnit S{pm, pn}; pg8::EpiKV E{(bf16_t*)(p.ws + WS_KVC)};
        pg8::gemm_phase<pg8::EpiKV, OneUnit>((LAS unsigned char*)lds, g, S, E);
        return;
    }
    const int blk = split ? blockIdx.x - 32 : blockIdx.x, nblk = split ? gridDim.x - 32 : gridDim.x;
    for (int it = blk; it < 256; it += nblk) filt4_item(lds, p, it);
    if (split && (nblk & 7) == 0) { const int xc = blk & 7;
        norm_rows(p.in[0] + (size_t)xc * SEQ * DM, nullptr, nullptr, HA, xc * SEQ, xc * SEQ + SEQ, p.in[6], mod, 0, 1, -1, blk >> 3, nblk >> 3); }
    else norm_rows(p.in[0], nullptr, nullptr, HA, 0, MTOK, p.in[6], mod, 0, 1, -1, blk, nblk);
    if (!split) norm_rows(p.in[2], nullptr, nullptr, HA, MTOK, MTOK + MCTX, p.in[6], mod, 0, 1, 8, blk, nblk);
}

DI void ret_state_item(unsigned char* lds, const Params& p, int item, int variant) {
    const int tid = threadIdx.x, lane = tid & 63, w = tid >> 6;
    const int b = item >> 3, h = (item >> 1) & 3, dir = item & 1, bh = b * 4 + h;
    const bf16_t* P = (const bf16_t*)(p.ws + WS_P);
    const bf16_t* KVC = (const bf16_t*)(p.ws + WS_KVC);
    bf16_t* ST = (bf16_t*)(p.ws + WS_ST);
    constexpr int RS_ROW = 304, RS_IMG = 128 * RS_ROW, RS_BUF = 2 * RS_IMG;
    const float lg = log1pf(-__expf(p.in[9][dir * 4 + h]));
    const float g128 = __expf(lg * 128.0f);
    const int segk = tid & 15, jk0 = tid >> 4;
    float wv[4];
#pragma unroll
    for (int i = 0; i < 4; ++i) { const int j = jk0 + 32 * i; wv[i] = dir == 0 ? __expf(lg * (float)(127 - j)) : __expf(lg * (float)j); }
    u32x4 kreg[2][4], vreg[2][4];
    f32x4 acc[8];
#pragma unroll
    for (int et = 0; et < 8; ++et) acc[et] = (f32x4){0.f, 0.f, 0.f, 0.f};
    const int G = lane >> 4, i16 = lane & 15, q = i16 >> 2, pp = i16 & 3, wd = w >> 2, we = w & 3;
#define RS_LOAD(s, R) do { \
        const bf16_t* kb; size_t ld; \
        if ((s) < 2) { const int cc = dir == 0 ? (s) : 1 - (s); kb = KVC + (size_t)(b * CTXL + cc * 128) * 1024 + h * 128; ld = 1024; } \
        else { const int n = dir == 0 ? (s) - 2 : 31 - ((s) - 2); kb = P + (size_t)(b * SEQ + n * 128) * DIN + 512 + h * 128; ld = DIN; } \
        _Pragma("unroll") for (int i = 0; i < 4; ++i) { kreg[R][i] = *(const u32x4*)(kb + (size_t)(jk0 + 32 * i) * ld + 8 * segk); vreg[R][i] = *(const u32x4*)(kb + 512 + (size_t)(jk0 + 32 * i) * ld + 8 * segk); } } while (0)
#define RS_STEP(s, R, STORE) do { \
        { \
            unsigned char* KI = lds + (R) * RS_BUF; unsigned char* VI = KI + RS_IMG; \
            _Pragma("unroll") for (int i = 0; i < 4; ++i) { \
                *(u32x4*)(KI + (jk0 + 32 * i) * RS_ROW + segk * 16) = kreg[R][i]; \
                const u32x4 vr = vreg[R][i]; const float ww = wv[i]; u32x4 o; o.x = pk2(bflo(vr.x) * ww, bfhi(vr.x) * ww); o.y = pk2(bflo(vr.y) * ww, bfhi(vr.y) * ww); o.z = pk2(bflo(vr.z) * ww, bfhi(vr.z) * ww); o.w = pk2(bflo(vr.w) * ww, bfhi(vr.w) * ww); \
                *(u32x4*)(VI + (jk0 + 32 * i) * RS_ROW + segk * 16) = o; } \
            lds_barrier(); \
            { const int s2_ = (s) + 2 < 33 ? (s) + 2 : 32; RS_LOAD(s2_, R); }        \
            _Pragma("unroll") for (int et = 0; et < 8; ++et) acc[et] *= g128; \
            const LAS unsigned char* kbase = (const LAS unsigned char*)KI; const LAS unsigned char* vbase = (const LAS unsigned char*)VI; \
            _Pragma("unroll") for (int ks = 0; ks < 4; ++ks) {        \
                const int j0 = 32 * ks + 8 * G + q; \
                bf16x8 ak[4], bv[2]; \
                _Pragma("unroll") for (int dt = 0; dt < 4; ++dt) ak[dt] = tr_read8(kbase + j0 * RS_ROW + (64 * wd + 16 * dt + 4 * pp) * 2, 4 * RS_ROW); \
                _Pragma("unroll") for (int et = 0; et < 2; ++et) bv[et] = tr_read8(vbase + j0 * RS_ROW + (32 * we + 16 * et + 4 * pp) * 2, 4 * RS_ROW); \
                _Pragma("unroll") for (int dt = 0; dt < 4; ++dt) \
                _Pragma("unroll") for (int et = 0; et < 2; ++et) acc[dt * 2 + et] = MFMA16(ak[dt], bv[et], acc[dt * 2 + et]); } \
            if (STORE) {        \
                const int n = dir == 0 ? (s) - 1 : 31 - ((s) - 1); \
                  \
                bf16_t* dst = ST + (((size_t)dir * 32 + bh) * 32 + n) * 16384 + (i16 + 16 * (G >> 1)) * 8 + 4 * (G & 1); \
                _Pragma("unroll") for (int dt = 0; dt < 4; ++dt) \
                _Pragma("unroll") for (int et = 0; et < 2; ++et) { const f32x4 a_ = acc[dt * 2 + et]; u32x2 o; o.x = pk2(a_[0], a_[1]); o.y = pk2(a_[2], a_[3]); \
                    *(u32x2*)(dst + (((2 * we + et) * 4 + 2 * wd + (dt >> 1)) * 64 + 32 * (dt & 1)) * 8) = o; } \
            } \
            __builtin_amdgcn_sched_barrier(0);        \
        } } while (0)
    RS_LOAD(0, 0);
    RS_LOAD(1, 1);
    RS_STEP(0, 0, false);
#pragma unroll 1
    for (int s = 1; s < 33; s += 2) { RS_STEP(s, 1, true); RS_STEP(s + 1, 0, true); }
    lds_barrier();
#undef RS_LOAD
#undef RS_STEP
}

DI void unpack8(const u32x4 v, float (&f)[8]) { f[0] = bflo(v.x); f[1] = bfhi(v.x); f[2] = bflo(v.y); f[3] = bfhi(v.y); f[4] = bflo(v.z); f[5] = bfhi(v.z); f[6] = bflo(v.w); f[7] = bfhi(v.w); }
DI void load8f(const float* p, float (&f)[8]) { const f32x4 a = *(const f32x4*)p, b = *(const f32x4*)(p + 4); f[0] = a[0]; f[1] = a[1]; f[2] = a[2]; f[3] = a[3]; f[4] = b[0]; f[5] = b[1]; f[6] = b[2]; f[7] = b[3]; }
DI void hy_u_items(unsigned char* lds, const Params& p, int it0, int stride, int n_items) {
    bf16_t* T = (bf16_t*)lds;
    const int tid = threadIdx.x, row = tid >> 3, seg = tid & 7;
    const bf16_t* Pg = (const bf16_t*)(p.ws + WS_P) + 2048 + 8 * seg;
    const u32x4 z4 = {0u, 0u, 0u, 0u};
    u32x4 xm, x0, xp, vm, v0, vp;
#define HU_LOAD(it) do { const int b_ = (it) >> 9, t_ = (((it) >> 3) & 63) * 64 + row, c0_ = ((it) & 7) * 64; const bf16_t* P_ = Pg + (size_t)b_ * SEQ * DIN + c0_; \
        xm = t_ > 0 ? *(const u32x4*)(P_ + (size_t)(t_ - 1) * DIN + 512) : z4; x0 = *(const u32x4*)(P_ + (size_t)t_ * DIN + 512); xp = t_ < SEQ - 1 ? *(const u32x4*)(P_ + (size_t)(t_ + 1) * DIN + 512) : z4; \
        vm = t_ > 0 ? *(const u32x4*)(P_ + (size_t)(t_ - 1) * DIN + 1024) : z4; v0 = *(const u32x4*)(P_ + (size_t)t_ * DIN + 1024); vp = t_ < SEQ - 1 ? *(const u32x4*)(P_ + (size_t)(t_ + 1) * DIN + 1024) : z4; } while (0)
    if (it0 < n_items) HU_LOAD(it0);
    int par = 0, wct = -1;
    float xw0[8], xw1[8], xw2[8], xbs[8], vw0[8], vw1[8], vw2[8], vbs[8];
    for (int item = it0; item < n_items; item += stride, par ^= 1) {
        const int b = item >> 9, tt = (item >> 3) & 63, ct = item & 7, t0 = tt * 64, c0 = ct * 64;
        if (ct != wct) { wct = ct; const float* sw = p.in[11] + c0 + 8 * seg; const float* sb = p.in[12] + c0 + 8 * seg;
            load8f(sw + 512, xw0); load8f(sw + 1536 + 512, xw1); load8f(sw + 3072 + 512, xw2); load8f(sb + 512, xbs);
            load8f(sw + 1024, vw0); load8f(sw + 1536 + 1024, vw1); load8f(sw + 3072 + 1024, vw2); load8f(sb + 1024, vbs); }
        float u[8];
        { float a[8], bb[8], c[8];
          unpack8(xm, a); unpack8(x0, bb); unpack8(xp, c);
#pragma unroll
          for (int k = 0; k < 8; ++k) u[k] = xbs[k] + xw0[k] * a[k] + xw1[k] * bb[k] + xw2[k] * c[k];
          unpack8(vm, a); unpack8(v0, bb); unpack8(vp, c);
#pragma unroll
          for (int k = 0; k < 8; ++k) u[k] *= vbs[k] + vw0[k] * a[k] + vw1[k] * bb[k] + vw2[k] * c[k]; }
        if (item + stride < n_items) HU_LOAD(item + stride);
        bf16_t* Tb = T + par * (64 * 72);
#pragma unroll
        for (int k = 0; k < 8; k += 2) { const unsigned pk = pk2(u[k], u[k + 1]); Tb[(8 * seg + k) * 72 + (row ^ (8 * seg))] = (bf16_t)(pk & 0xffffu); Tb[(8 * seg + k + 1) * 72 + (row ^ (8 * seg))] = (bf16_t)(pk >> 16); }
        lds_barrier();
        { const int cc = tid >> 3, sg = tid & 7;
          *(u32x4*)((bf16_t*)(p.ws + WS_U) + ((size_t)(c0 + cc) * NB + b) * SEQ + t0 + 8 * sg) = *(const u32x4*)(Tb + cc * 72 + 8 * (sg ^ ((cc >> 3) & 7))); }
    }
    lds_barrier();
#undef HU_LOAD
}

DI void ret_out_items(unsigned char* lds, const Params& p, int it0, int stride, int n_items) {
    const int tid = threadIdx.x, lane = tid & 63, w = tid >> 6;
    const bf16_t* P = (const bf16_t*)(p.ws + WS_P);
    const bf16_t* ST = (const bf16_t*)(p.ws + WS_ST);
    bf16_t* MIX = (bf16_t*)(p.ws + WS_MIXIN);
    constexpr int RO_ROW = 304, RO_IMG = 128 * RO_ROW;
    unsigned char* KB = lds;
    unsigned char* VB = lds + RO_IMG;
    unsigned char* SF = lds + 2 * RO_IMG;
    unsigned char* PI = lds + 2 * RO_IMG + 32768 + w * 5120;
    const int G = lane >> 4, i16 = lane & 15, q = i16 >> 2, pp = i16 & 3;
    const int segk = tid & 15, jk0 = tid >> 4;
    u32x4 kreg[4], vreg[4], sreg[4]; bf16x8 qf[4];
#define RO_LOAD(it) do { const int b_ = (it) >> 7, h_ = ((it) >> 5) & 3, n_ = (it) & 31; const size_t tok_ = (size_t)b_ * SEQ + n_ * 128; \
        const bf16_t* kb_ = P + tok_ * DIN + 512 + h_ * 128; const bf16_t* sf_ = ST + (((size_t)0 * 32 + b_ * 4 + h_) * 32 + n_) * 16384; \
        _Pragma("unroll") for (int i = 0; i < 4; ++i) { const int j_ = jk0 + 32 * i; kreg[i] = *(const u32x4*)(kb_ + (size_t)j_ * DIN + 8 * segk); vreg[i] = *(const u32x4*)(kb_ + 512 + (size_t)j_ * DIN + 8 * segk); \
            sreg[i] = *(const u32x4*)(sf_ + (size_t)(tid + NTHR * i) * 8); } \
        const bf16_t* qb_ = P + (tok_ + 16 * w + i16) * DIN + h_ * 128 + 8 * G; \
        _Pragma("unroll") for (int ks = 0; ks < 4; ++ks) qf[ks] = *(const bf16x8*)(qb_ + 32 * ks); } while (0)
    if (it0 < n_items) RO_LOAD(it0);
  for (int item = it0; item < n_items; item += stride) {
    const int b = item >> 7, h = (item >> 5) & 3, n = item & 31, bh = b * 4 + h;
    const float lgf = log1pf(-__expf(p.in[9][h])), lgb = log1pf(-__expf(p.in[9][4 + h]));
    const float lf2 = lgf * 1.4426950408889634f, lb2 = lgb * 1.4426950408889634f;
    const size_t tok0 = (size_t)b * SEQ + n * 128;
#pragma unroll
    for (int i = 0; i < 4; ++i) {
        const int j = jk0 + 32 * i;
        *(u32x4*)(KB + j * RO_ROW + segk * 16) = kreg[i];
        *(u32x4*)(VB + j * RO_ROW + segk * 16) = vreg[i];
        *(u32x4*)(SF + (tid + NTHR * i) * 16) = sreg[i];
    }
    u32x4 greg[4]; float gnr[8];
    { const bf16_t* gb = P + tok0 * DIN + 1536 + h * 128 + 8 * segk;
#pragma unroll
      for (int i = 0; i < 4; ++i) greg[i] = *(const u32x4*)(gb + (size_t)(jk0 + 32 * i) * DIN);
#pragma unroll
      for (int et = 0; et < 8; ++et) gnr[et] = p.in[10][h * 128 + 16 * et + i16]; }
    lds_barrier();
    int ibase = 16 * w + 4 * G;
    asm volatile("" : "+v"(ibase));
    {
        f32x4 accS[8];
#pragma unroll
        for (int jt = 0; jt < 8; ++jt) {
            accS[jt] = (f32x4){0.f, 0.f, 0.f, 0.f};
#pragma unroll
            for (int ks = 0; ks < 4; ++ks) { const bf16x8 bk = *(const bf16x8*)(KB + (16 * jt + i16) * RO_ROW + (32 * ks + 8 * G) * 2); accS[jt] = MFMA16(qf[ks], bk, accS[jt]); }
            if (jt & 1) __builtin_amdgcn_sched_barrier(0);
        }
#pragma unroll
        for (int jt = 0; jt < 8; ++jt) {
            const int j = 16 * jt + i16; float pv[4];
#pragma unroll
            for (int r = 0; r < 4; ++r) {
                const int diff = ibase + r - j;
                const float ex = __builtin_amdgcn_exp2f((diff > 0 ? lf2 : -lb2) * (float)diff);
                pv[r] = accS[jt][r] * (diff == 0 ? 2.0f : ex);
            }
            u32x2 o; o.x = pk2(pv[0], pv[1]); o.y = pk2(pv[2], pv[3]);
            *(u32x2*)(PI + j * 40 + 8 * G) = o;
        }
    }
    lds_barrier();
    { const bf16_t* sbp = ST + (((size_t)1 * 32 + bh) * 32 + n) * 16384;
#pragma unroll
      for (int i = 0; i < 4; ++i) *(u32x4*)(KB + (tid + NTHR * i) * 16) = *(const u32x4*)(sbp + (size_t)(tid + NTHR * i) * 8); }
    f32x4 accI[8];
    const LAS unsigned char* pbase = (const LAS unsigned char*)PI; const LAS unsigned char* vbase = (const LAS unsigned char*)VB;
#pragma unroll
    for (int et = 0; et < 8; ++et) accI[et] = (f32x4){0.f, 0.f, 0.f, 0.f};
#pragma unroll
    for (int ks = 0; ks < 4; ++ks) {
        const int j0 = 32 * ks + 8 * G + q;
        const bf16x8 ap = tr_read8(pbase + j0 * 40 + 8 * pp, 4 * 40);
#pragma unroll
        for (int et = 0; et < 8; ++et) {
            const bf16x8 bv = tr_read8(vbase + j0 * RO_ROW + (16 * et + 4 * pp) * 2, 4 * RO_ROW);
            accI[et] = MFMA16(ap, bv, accI[et]);
        }
        __builtin_amdgcn_sched_barrier(0);
    }
    float cf[4], cb[4];
#pragma unroll
    for (int r = 0; r < 4; ++r) { const int i = ibase + r; cf[r] = __builtin_amdgcn_exp2f(lf2 * (float)(i + 1)); cb[r] = __builtin_amdgcn_exp2f(lb2 * (float)(128 - i)); }
#pragma unroll
    for (int et = 0; et < 8; ++et) {
        f32x4 accX = (f32x4){0.f, 0.f, 0.f, 0.f};
#pragma unroll
        for (int ks = 0; ks < 4; ++ks) { const bf16x8 bs = *(const bf16x8*)(SF + ((et * 4 + ks) * 64 + lane) * 16); accX = MFMA16(qf[ks], bs, accX); }
#pragma unroll
        for (int r = 0; r < 4; ++r) accI[et][r] += cf[r] * accX[r];
        if (et & 1) __builtin_amdgcn_sched_barrier(0);
    }
    lds_barrier();
    unsigned char* GT = lds + 2 * RO_IMG + 32768;
#pragma unroll
    for (int i = 0; i < 4; ++i) *(u32x4*)(GT + (jk0 + 32 * i) * 272 + segk * 16) = greg[i];
#pragma unroll
    for (int et = 0; et < 8; ++et) {
        f32x4 accX = (f32x4){0.f, 0.f, 0.f, 0.f};
#pragma unroll
        for (int ks = 0; ks < 4; ++ks) { const bf16x8 bs = *(const bf16x8*)(KB + ((et * 4 + ks) * 64 + lane) * 16); accX = MFMA16(qf[ks], bs, accX); }
#pragma unroll
        for (int r = 0; r < 4; ++r) accI[et][r] += cb[r] * accX[r];
        if (et & 1) __builtin_amdgcn_sched_barrier(0);
    }
    if (item + stride < n_items) RO_LOAD(item + stride);
    lds_barrier();
#pragma unroll
    for (int r = 0; r < 4; ++r) {
        float s = 0.f;
#pragma unroll
        for (int et = 0; et < 8; ++et) s += accI[et][r];
        s += __shfl_xor(s, 1); s += __shfl_xor(s, 2); s += __shfl_xor(s, 4); s += __shfl_xor(s, 8);
        const float mu = s * (1.0f / 128.0f);
        float v = 0.f;
#pragma unroll
        for (int et = 0; et < 8; ++et) { const float d = accI[et][r] - mu; v += d * d; }
        v += __shfl_xor(v, 1); v += __shfl_xor(v, 2); v += __shfl_xor(v, 4); v += __shfl_xor(v, 8);
        const float rstd = rsqrtf(v * (1.0f / 128.0f) + EPSF);
        bf16_t* grow = (bf16_t*)(GT + (16 * w + 4 * G + r) * 272) + i16;
#pragma unroll
        for (int et = 0; et < 8; ++et) {
            const float g = bf2f(grow[16 * et]);
            grow[16 * et] = f2bf((accI[et][r] - mu) * rstd * gnr[et] * (g * __builtin_amdgcn_rcpf(1.0f + __builtin_amdgcn_exp2f(-1.4426950408889634f * g))));
        }
    }
    lds_barrier();
#pragma unroll
    for (int i = 0; i < 4; ++i) { const int j = jk0 + 32 * i; *(u32x4*)(MIX + (tok0 + j) * DM + h * 128 + 8 * segk) = *(const u32x4*)(GT + j * 272 + segk * 16); }
    lds_barrier();
  }
#undef RO_LOAD
}

constexpr int KR_OFF = 4112, KR_N = 8208, KR_BYTES = 16640, USH_ROW = 1040, USH_BYTES = 64 * USH_ROW;
DI void conv_item(unsigned char* lds, const Params& p, int c) {
    const int tid = threadIdx.x, lane = tid & 63, w = tid >> 6;
    bf16_t* KR = (bf16_t*)lds;
    unsigned char* USH = lds + KR_BYTES;
    const bf16_t* Ug = (const bf16_t*)(p.ws + WS_U) + (size_t)c * NB * SEQ;
    bf16_t* Yg = (bf16_t*)(p.ws + WS_YC) + (size_t)c * NB * SEQ;
    { const float* kf = (const float*)(p.ws + WS_KERN) + (size_t)c * SEQ; const float* kb = kf + (size_t)512 * SEQ;
      const float sc = 1.0f / (((const float*)(p.ws + WS_KSUM))[c] + EPSF);
      float kv[17];
#pragma unroll
      for (int k = 0; k < 17; ++k) {
          const int y = tid + NTHR * k, m = KR_OFF - y, am = m < 0 ? -m : m, ai = am < SEQ ? am : SEQ - 1;
          kv[k] = (m >= 0 ? kf : kb)[ai];
          if (am >= SEQ) kv[k] = 0.f;
      }
#pragma unroll
      for (int k = 0; k < 17; ++k) { const int y = tid + NTHR * k; if (y < KR_N + 8) KR[y] = f2bf(kv[k] * sc); } }
    const int rh = tid >> 8, sb = (tid >> 5) & 7, sg = tid & 31;
    u32x4 lo[2], hi[2];
#define CV_LOAD(qc) do { _Pragma("unroll") for (int h2 = 0; h2 < 2; ++h2) { const int e0 = -16 + 512 * (qc) + 256 * h2 + 8 * sg, e1 = e0 + 8; \
        lo[h2] = (e0 >= 0 && e0 < SEQ) ? *(const u32x4*)(Ug + (size_t)sb * SEQ + e0) : (u32x4){0u, 0u, 0u, 0u}; \
        hi[h2] = (e1 >= 0 && e1 < SEQ) ? *(const u32x4*)(Ug + (size_t)sb * SEQ + e1) : (u32x4){0u, 0u, 0u, 0u}; } } while (0)
#define CV_WIN(r, dst, h2) do { const unsigned wv[8] = {lo[h2].x, lo[h2].y, lo[h2].z, lo[h2].w, hi[h2].x, hi[h2].y, hi[h2].z, hi[h2].w}; constexpr int e_ = (r) >> 1; u32x4 o_; \
        if ((r) & 1) { o_.x = (wv[e_] >> 16) | (wv[e_ + 1] << 16); o_.y = (wv[e_ + 1] >> 16) | (wv[e_ + 2] << 16); o_.z = (wv[e_ + 2] >> 16) | (wv[e_ + 3] << 16); o_.w = (wv[e_ + 3] >> 16) | (wv[e_ + 4] << 16); } \
        else { o_.x = wv[e_]; o_.y = wv[e_ + 1]; o_.z = wv[e_ + 2]; o_.w = wv[e_ + 3]; } \
        *(u32x4*)((dst) + (sb * 8 + (r)) * USH_ROW + (h2) * 512 + sg * 16) = o_; } while (0)
#define CV_STORE(buf) do { unsigned char* d_ = USH + (buf) * USH_BYTES; \
        if (rh == 0) { CV_WIN(0, d_, 0); CV_WIN(1, d_, 0); CV_WIN(2, d_, 0); CV_WIN(3, d_, 0); CV_WIN(0, d_, 1); CV_WIN(1, d_, 1); CV_WIN(2, d_, 1); CV_WIN(3, d_, 1); } \
        else { CV_WIN(4, d_, 0); CV_WIN(5, d_, 0); CV_WIN(6, d_, 0); CV_WIN(7, d_, 0); CV_WIN(4, d_, 1); CV_WIN(5, d_, 1); CV_WIN(6, d_, 1); CV_WIN(7, d_, 1); } } while (0)
    f32x16 acc[2][2];
#pragma unroll
    for (int a = 0; a < 2; ++a)
#pragma unroll
        for (int b2 = 0; b2 < 2; ++b2)
#pragma unroll
            for (int k = 0; k < 16; ++k) acc[a][b2][k] = 0.f;
    const int i32 = lane & 31, hh = lane >> 5;
    const int ya0 = KR_OFF - 256 * (2 * w) - 8 * i32 - 16 + 8 * hh, ya1 = ya0 - 256;
    const int brow0 = i32 * USH_ROW + hh * 16, brow1 = brow0 + 32 * USH_ROW;
    CV_LOAD(0);
    CV_STORE(0);
    CV_LOAD(1);
    lds_barrier();
#define CV_FRAGS(st_, A0, A1, B0, B1) do { const int sg16_ = (qc * 32 + hf * 16 + (st_)) * 16; \
        A0 = *(const bf16x8*)(KR + ya0 + sg16_); A1 = *(const bf16x8*)(KR + ya1 + sg16_); \
        B0 = *(const bf16x8*)(ub + brow0 + (hf * 16 + (st_)) * 32); B1 = *(const bf16x8*)(ub + brow1 + (hf * 16 + (st_)) * 32); } while (0)
#define CV_MMA(A0, A1, B0, B1) do { acc[0][0] = MFMA32(A0, B0, acc[0][0]); acc[0][1] = MFMA32(A0, B1, acc[0][1]); acc[1][0] = MFMA32(A1, B0, acc[1][0]); acc[1][1] = MFMA32(A1, B1, acc[1][1]); } while (0)
#pragma unroll 1
    for (int qc = 0; qc < 9; ++qc) {
        if (qc + 1 < 9) CV_STORE((qc + 1) & 1);
        if (qc + 2 < 9) CV_LOAD(qc + 2);
        const unsigned char* ub = USH + (qc & 1) * USH_BYTES;
        bf16x8 fa0, fa1, fb0, fb1, ga0, ga1, gb0, gb1;
        if (qc < 8) {
#pragma unroll 1
            for (int hf = 0; hf < 2; ++hf) {
                CV_FRAGS(0, fa0, fa1, fb0, fb1);
#pragma unroll
                for (int st = 0; st < 16; st += 2) {
                    CV_FRAGS(st + 1, ga0, ga1, gb0, gb1);
                    CV_MMA(fa0, fa1, fb0, fb1);
                    if (st + 2 < 16) CV_FRAGS(st + 2, fa0, fa1, fb0, fb1);
                    CV_MMA(ga0, ga1, gb0, gb1);
                }
            }
        } else { const int hf = 0; CV_FRAGS(0, fa0, fa1, fb0, fb1); CV_MMA(fa0, fa1, fb0, fb1); }
        lds_barrier();
    }
#undef CV_FRAGS
#undef CV_MMA
#pragma unroll
    for (int mi = 0; mi < 2; ++mi)
#pragma unroll
        for (int nt = 0; nt < 2; ++nt)
#pragma unroll
            for (int reg = 0; reg < 16; reg += 2) {
                const int i = (reg & 3) + 8 * (reg >> 2) + 4 * hh, bb = 4 * nt + (i32 >> 3), r = i32 & 7;
                const unsigned pk = pk2(acc[mi][nt][reg], acc[mi][nt][reg + 1]);
                bf16_t* yp = Yg + (size_t)bb * SEQ + 256 * (2 * w + mi) + 8 * i + r;
                yp[0] = (bf16_t)(pk & 0xffffu); yp[8] = (bf16_t)(pk >> 16);
            }
    lds_barrier();
#undef CV_LOAD
#undef CV_WIN
#undef CV_STORE
}

DI void hy_fin_item(unsigned char* lds, const Params& p, int item) {
    float* Z = (float*)lds;
    const int tid = threadIdx.x, lane = tid & 63, w = tid >> 6;
    const int b = item >> 6, t0 = (item & 63) * 64;
    { const int c = tid; const float bias = p.in[21][c];
      const bf16_t* yc = (const bf16_t*)(p.ws + WS_YC) + ((size_t)c * NB + b) * SEQ + t0;
      const bf16_t* uu = (const bf16_t*)(p.ws + WS_U) + ((size_t)c * NB + b) * SEQ + t0;
#pragma unroll 8
      for (int seg = 0; seg < 8; ++seg) {
          const u32x4 yv = *(const u32x4*)(yc + 8 * seg), uv = *(const u32x4*)(uu + 8 * seg);
          const unsigned ya[4] = {yv.x, yv.y, yv.z, yv.w}, ua[4] = {uv.x, uv.y, uv.z, uv.w};
#pragma unroll
          for (int k = 0; k < 4; ++k) {
              Z[(8 * seg + 2 * k) * 516 + c] = bflo(ya[k]) + bflo(ua[k]) * bias;
              Z[(8 * seg + 2 * k + 1) * 516 + c] = bfhi(ya[k]) + bfhi(ua[k]) * bias;
          }
      } }
    lds_barrier();
    const bf16_t* P = (const bf16_t*)(p.ws + WS_P) + (size_t)b * SEQ * DIN + 2048 + 8 * lane;
    bf16_t* MIX = (bf16_t*)(p.ws + WS_MIXIN) + (size_t)b * SEQ * DM + 512 + 8 * lane;
    float w0[8], w1[8], w2[8], bs[8], og[8];
    load8f(p.in[11] + 8 * lane, w0); load8f(p.in[11] + 1536 + 8 * lane, w1); load8f(p.in[11] + 3072 + 8 * lane, w2); load8f(p.in[12] + 8 * lane, bs); load8f(p.in[22] + 8 * lane, og);
    const int ts = t0 + 8 * w;
    u32x4 rows[10];
#pragma unroll
    for (int r = 0; r < 10; ++r) { const int t = ts - 1 + r; rows[r] = (t >= 0 && t < SEQ) ? *(const u32x4*)(P + (size_t)t * DIN) : (u32x4){0u, 0u, 0u, 0u}; }
#pragma unroll
    for (int tt = 0; tt < 8; ++tt) {
        const int tl = 8 * w + tt;
        float am[8], a0[8], ap[8], z[8], y[8];
        unpack8(rows[tt], am); unpack8(rows[tt + 1], a0); unpack8(rows[tt + 2], ap);
        load8f(Z + tl * 516 + 8 * lane, z);
        float ss = 0.f;
#pragma unroll
        for (int k = 0; k < 8; ++k) { y[k] = (bs[k] + w0[k] * am[k] + w1[k] * a0[k] + w2[k] * ap[k]) * z[k]; ss += y[k] * y[k]; }
        ss = wave_sum(ss);
        const float rstd = rsqrtf(ss * (1.0f / 512.0f) + EPSF);
        u32x4 o; o.x = pk2(y[0] * rstd * og[0], y[1] * rstd * og[1]); o.y = pk2(y[2] * rstd * og[2], y[3] * rstd * og[3]); o.z = pk2(y[4] * rstd * og[4], y[5] * rstd * og[5]); o.w = pk2(y[6] * rstd * og[6], y[7] * rstd * og[7]);
        *(u32x4*)(MIX + (size_t)(ts + tt) * DM) = o;
    }
    lds_barrier();
}

struct FinRow { f32x4 v[4]; u32x2 a[4], b[4]; };
DI void frow_load(FinRow& R, const float* x, const bf16_t* a, const bf16_t* b, int lane) {
#pragma unroll
    for (int k = 0; k < 4; ++k) { const int c = 4 * lane + 256 * k; R.v[k] = __builtin_nontemporal_load((const f32x4*)(x + c)); R.a[k] = __builtin_nontemporal_load((const u32x2*)(a + c)); R.b[k] = __builtin_nontemporal_load((const u32x2*)(b + c)); }
}
DI void final_norm_rows(const float* x, const bf16_t* mg, const bf16_t* fg, float* out, const float* gain) {
    const int xb = (gridDim.x & 7) ? (int)blockIdx.x : (int)((blockIdx.x & 7) * (gridDim.x >> 3) + (blockIdx.x >> 3));
    const int lane = threadIdx.x & 63, w = threadIdx.x >> 6, nw = gridDim.x * 8, wid = xb * 8 + w;
    const int per = (MTOK + nw - 1) / nw, r0 = wid * per, r1 = (r0 + per < MTOK) ? r0 + per : MTOK;
    if (r0 >= r1) return;
    f32x4 g[4];
#pragma unroll
    for (int k = 0; k < 4; ++k) g[k] = *(const f32x4*)(gain + 4 * lane + 256 * k);
    FinRow R[4];
#define FN_LOAD(set, row) frow_load(R[set], x + (size_t)(row) * DM, mg + (size_t)(row) * DM, fg + (size_t)(row) * DM, lane)
#define FN_STEP(u, row) do { if ((row) < r1) { \
        if ((row) + 3 < r1) FN_LOAD(((u) + 3) & 3, (row) + 3); \
        FinRow& Q = R[u]; float ss = 0.f; \
        _Pragma("unroll") for (int k = 0; k < 4; ++k) { Q.v[k] += (f32x4){bflo(Q.a[k].x), bfhi(Q.a[k].x), bflo(Q.a[k].y), bfhi(Q.a[k].y)}; Q.v[k] += (f32x4){bflo(Q.b[k].x), bfhi(Q.b[k].x), bflo(Q.b[k].y), bfhi(Q.b[k].y)}; \
            ss += Q.v[k][0] * Q.v[k][0] + Q.v[k][1] * Q.v[k][1] + Q.v[k][2] * Q.v[k][2] + Q.v[k][3] * Q.v[k][3]; } \
        ss = wave_sum(ss); \
        const float rstd = rsqrtf(ss * (1.0f / DM) + EPSF); \
        _Pragma("unroll") for (int k = 0; k < 4; ++k) *(f32x4*)(out + (size_t)(row) * DM + 4 * lane + 256 * k) = Q.v[k] * rstd * g[k]; \
    } } while (0)
    FN_LOAD(0, r0); if (r0 + 1 < r1) FN_LOAD(1, r0 + 1); if (r0 + 2 < r1) FN_LOAD(2, r0 + 2);
#pragma unroll 1
    for (int r = r0; r < r1; r += 4) { FN_STEP(0, r); FN_STEP(1, r + 1); FN_STEP(2, r + 2); FN_STEP(3, r + 3); }
#undef FN_LOAD
#undef FN_STEP
}

#ifndef PROBE_VARIANT
#define PROBE_VARIANT 0
#endif
#ifndef PROBE_PH
#define PROBE_PH -1
#endif
constexpr int NPH = 13;
constexpr unsigned SYNC_AFTER = 0x0FD7u;
__global__ void __launch_bounds__(NTHR, 2) fwd_kernel(Params p, int ph_lo, int ph_hi, int variant) {
    extern __shared__ __attribute__((aligned(16))) unsigned char lds[];
    cg::grid_group grid = cg::this_grid();
    LAS unsigned char* lds3 = (LAS unsigned char*)lds;
    volatile LAS unsigned* bst = (volatile LAS unsigned*)(lds3 + LDS_BYTES - 16);
    if (threadIdx.x < 4) bst[threadIdx.x] = 0u;
    __syncthreads();
    XcdBarrier xbar = xcd_barrier_post((unsigned*)(p.ws + WS_BAR), bst);
    if (ph_hi < 0) grid.sync();
    unsigned char* ws = p.ws;
    const float* MOD = (const float*)(ws + WS_MOD);
    const int xblk = (gridDim.x & 7) ? (int)blockIdx.x : (int)((blockIdx.x & 7) * (gridDim.x >> 3) + (blockIdx.x >> 3));
#ifndef ONLYPH
#define ONLYPH -1
#endif
#define RUN(k) ((ONLYPH < 0 || ONLYPH == (k)) && ph_lo <= (k) && (k) < ph_hi)
#define SEAM(k) do { if (((SYNC_AFTER >> (k)) & 1u) && RUN(k) && (k) + 1 < ph_hi) xcd_barrier(xbar); } while (0)
    if (RUN(0)) phase0(lds, p);
    SEAM(0);
    if (RUN(1)) phase1(lds, p);
    SEAM(1);
    if (RUN(2)) {
        { pg8::Gemm g{(const bf16_t*)(ws + WS_HA), (const bf16_t*)(ws + WS_WIN), MTOK, DIN, DM}; pg8::StaticOrder S; S.init(MTOK, DIN, gridDim.x, blockIdx.x);
          pg8::EpiP E{(bf16_t*)(ws + WS_P), (const float*)(ws + WS_ROPE)};
          pg8::gemm_phase<pg8::EpiP, pg8::StaticOrder>(lds3, g, S, E); }
        if (gridDim.x < 64) { pg8::Gemm g{(const bf16_t*)(ws + WS_HA) + (size_t)MTOK * DM, (const bf16_t*)(ws + WS_WIN) + (size_t)512 * DM, MCTX, 1024, DM}; pg8::StaticOrder S; S.init(MCTX, 1024, gridDim.x, blockIdx.x);
          pg8::EpiKV E{(bf16_t*)(ws + WS_KVC)};
          pg8::gemm_phase<pg8::EpiKV, pg8::StaticOrder>(lds3, g, S, E); }
    }
    SEAM(2);
    const bool split34 = RUN(3) && RUN(4) && gridDim.x >= 128;
    if (RUN(3)) { if (split34) { if (blockIdx.x < 64) ret_state_item(lds, p, blockIdx.x, variant); } else for (int it = blockIdx.x; it < 64; it += gridDim.x) ret_state_item(lds, p, it, variant); }
    SEAM(3);
    if (RUN(4)) {
        constexpr int T_ALL = T_WIN + T_WOUT + T_WGU + T_WDN;
        if (split34) { if (blockIdx.x >= 64) { hy_u_items(lds, p, blockIdx.x - 64, gridDim.x - 64, 4096); transpose_tiles(lds, p, T_WIN + blockIdx.x - 64, gridDim.x - 64, T_ALL); } }
        else { hy_u_items(lds, p, blockIdx.x, gridDim.x, 4096); transpose_tiles(lds, p, T_WIN + blockIdx.x, gridDim.x, T_ALL); }
    }
    SEAM(4);
    if (RUN(6)) ret_out_items(lds, p, blockIdx.x, gridDim.x, 1024);
    if (RUN(5)) { for (int it = blockIdx.x; it < 512; it += gridDim.x) conv_item(lds, p, it); }
    SEAM(6);
    if (RUN(7)) { for (int it = blockIdx.x; it < 512; it += gridDim.x) hy_fin_item(lds, p, it); }
    SEAM(7);
    if (RUN(8)) {
        pg8::Gemm g{(const bf16_t*)(ws + WS_MIXIN), (const bf16_t*)(ws + WS_WOUT), MTOK, DM, DM}; pg8::StaticOrder S; S.init(MTOK, DM, gridDim.x, blockIdx.x);
        pg8::EpiGateBf E{(bf16_t*)(ws + WS_MG), MOD + 2 * 1024};
        pg8::gemm_phase<pg8::EpiGateBf, pg8::StaticOrder>(lds3, g, S, E);
    }
    SEAM(8);
    if (RUN(9)) norm_rows(p.in[0], (const bf16_t*)(ws + WS_MG), nullptr, (bf16_t*)(ws + WS_H2), 0, MTOK, p.in[7], MOD, 3, 4, -1, xblk, gridDim.x);
    SEAM(9);
    if (RUN(10)) {
        pg8::Gemm g{(const bf16_t*)(ws + WS_H2), (const bf16_t*)(ws + WS_WGU), MTOK, 2 * DFF, DM}; pg8::StaticOrder S; S.init(MTOK, 2 * DFF, gridDim.x, blockIdx.x);
        pg8::EpiSwiGLU E{(bf16_t*)(ws + WS_ACT)};
        pg8::gemm_phase<pg8::EpiSwiGLU, pg8::StaticOrder>(lds3, g, S, E);
    }
    SEAM(10);
    if (RUN(11)) {
        pg8::Gemm g{(const bf16_t*)(ws + WS_ACT), (const bf16_t*)(ws + WS_WDN), MTOK, DM, DFF}; pg8::StaticOrder S; S.init(MTOK, DM, gridDim.x, blockIdx.x);
        pg8::EpiGateBf E{(bf16_t*)(ws + WS_FG), MOD + 5 * 1024};
        pg8::gemm_phase<pg8::EpiGateBf, pg8::StaticOrder>(lds3, g, S, E);
    }
    SEAM(11);
    if (RUN(12)) final_norm_rows(p.in[0], (const bf16_t*)(ws + WS_MG), (const bf16_t*)(ws + WS_FG), p.out, p.in[26]);
#undef RUN
#undef SEAM
}

extern "C" void kernel_launch(void* const* d_in, const int* in_sizes, int n_in, void* d_out, int out_size, void* d_ws, size_t ws_size, hipStream_t stream) {
    static int grid = 0;
    if (grid == 0) {
        if (n_in != 27 || ws_size < WS_END) { fprintf(stderr, "kernel_launch: unexpected n_in %d or ws_size %zu (< %zu)\n", n_in, ws_size, (size_t)WS_END); grid = -1; return; }
        int dev = 0, cus = 0, per_cu = 0;
        hipGetDevice(&dev);
        hipDeviceGetAttribute(&cus, hipDeviceAttributeMultiprocessorCount, dev);
        if (hipFuncSetAttribute((const void*)fwd_kernel, hipFuncAttributeMaxDynamicSharedMemorySize, LDS_BYTES) != hipSuccess) { fprintf(stderr, "kernel_launch: hipFuncSetAttribute failed\n"); grid = -1; return; }
        hipOccupancyMaxActiveBlocksPerMultiprocessor(&per_cu, (const void*)fwd_kernel, NTHR, LDS_BYTES);
        if (per_cu < 1) { fprintf(stderr, "kernel_launch: occupancy query says %d blocks per CU\n", per_cu); per_cu = 1; }
        (void)hipGetLastError();
        grid = cus * 1;
    }
    if (grid < 0) return;
    Params p{};
    for (int i = 0; i < 27; ++i) p.in[i] = (const float*)d_in[i];
    p.out = (float*)d_out; p.ws = (unsigned char*)d_ws;
#if defined(MULTI_LAUNCH)
    for (int k = 0; k < NPH; ++k) { int lo = k, hi = k + 1; (void)hipMemsetAsync((unsigned char*)d_ws + WS_BAR, 0, XCD_BAR_WORDS * 4, stream); hipLaunchKernelGGL(fwd_kernel, dim3(grid), dim3(NTHR), LDS_BYTES, stream, p, lo, hi, 0); }
#else
    const int nl = PROBE_PH >= 0 ? 2 : 1;
    for (int li = 0; li < nl; ++li) {
        int lo = (PROBE_PH >= 0 && li == 1) ? PROBE_PH : 0, hi = (PROBE_PH >= 0 && li == 0) ? PROBE_PH + 1 : NPH;
        int var = (PROBE_PH >= 0 && li == 0) ? PROBE_VARIANT : 0;
        (void)hipMemsetAsync((unsigned char*)d_ws + WS_BAR, 0, XCD_BAR_WORDS * 4, stream);
        void* args[] = {&p, &lo, &hi, &var};
        hipError_t e = hipLaunchCooperativeKernel((const void*)fwd_kernel, dim3(grid), dim3(NTHR), args, LDS_BYTES, stream);
        if (e != hipSuccess) fprintf(stderr, "cooperative launch failed: %s (grid %d)\n", hipGetErrorString(e), grid);
    }
#endif
}
```

```cpp
#include <hip/hip_runtime.h>
#include <hip/hip_cooperative_groups.h>
#include <cstdio>
namespace cg = cooperative_groups;

#define DI __device__ __forceinline__
#define LAS __attribute__((address_space(3)))
#define PG8_LAS __attribute__((address_space(3)))
typedef unsigned short bf16_t;
typedef short bf16x8 __attribute__((ext_vector_type(8)));
typedef short s16x4 __attribute__((ext_vector_type(4)));
typedef float f32x4 __attribute__((ext_vector_type(4)));
typedef float f32x16 __attribute__((ext_vector_type(16)));
typedef unsigned u32x4 __attribute__((ext_vector_type(4)));
typedef unsigned u32x2 __attribute__((ext_vector_type(2)));

constexpr int NB = 8, SEQ = 4096, DM = 1024, MTOK = NB * SEQ, CTXL = 256, MCTX = NB * CTXL;
constexpr int DIN = 3584, DFF = 2816, NH = 4, DHD = 128, NMOD = 6;
constexpr float EPSF = 1e-6f;
constexpr int NTHR = 512;
constexpr int LDS_BYTES = 160 * 1024;

constexpr size_t WS_WIN = 0;
constexpr size_t WS_WOUT = WS_WIN + (size_t)DIN * DM * 2;
constexpr size_t WS_WGU = WS_WOUT + (size_t)DM * DM * 2;
constexpr size_t WS_WDN = WS_WGU + (size_t)2 * DFF * DM * 2;
constexpr size_t WS_MOD = WS_WDN + (size_t)DM * DFF * 2;
constexpr size_t WS_ROPE = WS_MOD + (size_t)9 * 6144 * 4;
constexpr size_t WS_FH3 = WS_ROPE + (size_t)SEQ * 64 * 2 * 4;
constexpr size_t WS_KERN = WS_FH3 + (size_t)SEQ * 64 * 4;
constexpr size_t WS_KSUM = WS_KERN + (size_t)2 * 512 * SEQ * 4;
constexpr size_t WS_MISC = WS_KSUM + 2048;
constexpr size_t WS_BAR = WS_MISC + 4096 + 2048;
constexpr size_t WS_KVC = WS_BAR + 16384;
constexpr size_t WS_HA = WS_KVC + (size_t)MCTX * 1024 * 2;
constexpr size_t WS_P = WS_HA + (size_t)(MTOK + MCTX) * DM * 2;
constexpr size_t WS_ST = WS_P + (size_t)MTOK * DIN * 2;
constexpr size_t WS_U = WS_ST + (size_t)2 * 32 * 32 * 16384 * 2;
constexpr size_t WS_YC = WS_U + (size_t)512 * NB * SEQ * 2;
constexpr size_t WS_END = WS_YC + (size_t)512 * NB * SEQ * 2;
constexpr size_t WS_MIXIN = WS_HA, WS_H2 = WS_HA, WS_ACT = WS_P;
constexpr size_t WS_MG = WS_ST, WS_FG = WS_HA;

struct Params { const float* in[27]; float* out; unsigned char* ws; };

DI unsigned short f2bf(float f) { unsigned u = __float_as_uint(f); u += 0x7FFFu + ((u >> 16) & 1u); return (unsigned short)(u >> 16); }
DI float bf2f(unsigned short b) { return __uint_as_float(((unsigned)b) << 16); }
typedef __bf16 bf16x2_t __attribute__((ext_vector_type(2)));
typedef float f32x2_t __attribute__((ext_vector_type(2)));
DI unsigned pk2(float lo, float hi) { const f32x2_t v = {lo, hi}; const bf16x2_t r = __builtin_convertvector(v, bf16x2_t); return __builtin_bit_cast(unsigned, r); }
DI float bflo(unsigned w) { return __uint_as_float(w << 16); }
DI float bfhi(unsigned w) { return __uint_as_float(w & 0xffff0000u); }
DI float wave_sum(float v) {
#pragma unroll
    for (int o = 32; o > 0; o >>= 1) v += __shfl_xor(v, o);
    return v;
}
DI float sigmoidf_(float x) { return __builtin_amdgcn_rcpf(1.0f + __builtin_amdgcn_exp2f(-1.4426950408889634f * x)); }
#define MFMA16(a, b, c) __builtin_amdgcn_mfma_f32_16x16x32_bf16((a), (b), (c), 0, 0, 0)
#define MFMA32(a, b, c) __builtin_amdgcn_mfma_f32_32x32x16_bf16((a), (b), (c), 0, 0, 0)

DI bf16x8 tr_read8(const LAS unsigned char* p, int hi_off) {
    const s16x4 lo = __builtin_amdgcn_ds_read_tr16_b64_v4i16((LAS s16x4*)p);
    const s16x4 hi = __builtin_amdgcn_ds_read_tr16_b64_v4i16((LAS s16x4*)(p + hi_off));
    return __builtin_shufflevector(lo, hi, 0, 1, 2, 3, 4, 5, 6, 7);
}
DI void lds_barrier() { asm volatile("s_waitcnt lgkmcnt(0)" ::: "memory"); __builtin_amdgcn_s_barrier(); asm volatile("" ::: "memory"); }
namespace pg8 {
constexpr int BM = 256, BK = 64, HALF = 128, HTB = HALF * BK * 2  , STAGE_BYTES = 8 * HTB, NXCD = 8, WGM = 1;

__host__ __device__ __forceinline__ int lds_byte(int r, int c) { const int st = (r >> 4) * 2 + (c >> 5), rr = r & 15, cc = c & 31, ob = rr * 64 + cc * 2; return st * 1024 + (ob ^ (((ob >> 9) & 1) << 5)); }
__host__ __device__ __forceinline__ void stage_rc(int b, int& R, int& C) { const int st = b / 1024, sb = b % 1024, swz = sb ^ (((sb >> 9) & 1) << 5); R = (st >> 1) * 16 + swz / 64; C = (st & 1) * 32 + (swz % 64) / 2; }
__host__ __device__ __forceinline__ int perm32(int rho) { const int n = rho >> 4, i = rho & 15; return 8 * (i >> 2) + 4 * n + (i & 3); }

struct Unit { int pm, pn; };
struct Gemm { const bf16_t* A; const bf16_t* Bt; int M, N, K; };

struct StaticOrder {
    int nM, nN, nwg, G, c;
    __host__ __device__ void init(int M, int N, int G_, int c_) { nM = M / BM; nN = N / BM; nwg = nM * nN; G = G_; c = c_; }
    __host__ __device__ bool next(int i, Unit& u) const {
        const long L = (long)i * G + c; if (L >= nwg) return false;
        int wgid = (int)L; { const int q = nwg / NXCD, r = nwg % NXCD, xcd = wgid % NXCD, off = wgid / NXCD; wgid = (xcd < r ? xcd * (q + 1) : r * (q + 1) + (xcd - r) * q) + off; }
        const int nig = WGM * nN, gid = wgid / nig, fm = gid * WGM, gsz = (nM - fm) < WGM ? (nM - fm) : WGM;
        u.pm = fm + ((wgid % nig) % gsz); u.pn = (wgid % nig) / gsz; return true;
    }
    __device__ __forceinline__ void a_ready(const Unit&) const {}
    __device__ __forceinline__ void done(const Unit&) const {}
};

struct EpiP {
    static constexpr bool PERM = true, AFTER_DRAIN = false;
    bf16_t* P; const float* rope;
    __device__ __forceinline__ void operator()(const f32x4 (&acc)[2][2][4][2], const Unit& u, int wr, int wc, int fr, int fq) const {
        const int row0 = u.pm * BM + wr * 64 + fr, col0 = u.pn * BM + wc * 32 + 8 * fq;
        const int mode = u.pn < 2 ? 1 : (u.pn < 4 ? 2 : 0);
        const float sc = mode == 2 ? 0.08838834764831845f : 1.0f;
        const int mp = 16 * wc + 4 * fq;
#pragma unroll
        for (int ai = 0; ai < 2; ++ai) {
          f32x4 rr0[4], rr1[4];
#pragma unroll
          for (int m = 0; m < 4; ++m) { rr0[m] = (f32x4){1.f, 0.f, 1.f, 0.f}; rr1[m] = rr0[m];
              if (mode) { const float* rp = rope + ((size_t)((row0 + ai * HALF + m * 16) & (SEQ - 1)) * 64 + mp) * 2; rr0[m] = *(const f32x4*)rp; rr1[m] = *(const f32x4*)(rp + 4); } }
          asm volatile("" ::: "memory");
#pragma unroll
            for (int m = 0; m < 4; ++m) {
                const int row = row0 + ai * HALF + m * 16;
                bf16_t* rowp = P + (size_t)row * DIN + col0;
                const f32x4 r0 = rr0[m], r1 = rr1[m];
#pragma unroll
                for (int bj = 0; bj < 2; ++bj) {
                    f32x4 v0 = acc[ai][bj][m][0], v1 = acc[ai][bj][m][1];
                    if (mode) {
                        f32x4 a, b;
                        a[0] = v0[0] * r0[0] - v0[1] * r0[1]; a[1] = v0[0] * r0[1] + v0[1] * r0[0];
                        a[2] = v0[2] * r0[2] - v0[3] * r0[3]; a[3] = v0[2] * r0[3] + v0[3] * r0[2];
                        b[0] = v1[0] * r1[0] - v1[1] * r1[1]; b[1] = v1[0] * r1[1] + v1[1] * r1[0];
                        b[2] = v1[2] * r1[2] - v1[3] * r1[3]; b[3] = v1[2] * r1[3] + v1[3] * r1[2];
                        v0 = a * sc; v1 = b * sc;
                    }
                    u32x4 w; w.x = pk2(v0[0], v0[1]); w.y = pk2(v0[2], v0[3]); w.z = pk2(v1[0], v1[1]); w.w = pk2(v1[2], v1[3]);
                    *(u32x4*)(rowp + bj * HALF) = w;
                }
            }
          asm volatile("" ::: "memory");
        }
    }
};
struct EpiKV {
    static constexpr bool PERM = true, AFTER_DRAIN = false;
    bf16_t* O;
    __device__ __forceinline__ void operator()(const f32x4 (&acc)[2][2][4][2], const Unit& u, int wr, int wc, int fr, int fq) const {
        const int row0 = u.pm * BM + wr * 64 + fr, col0 = u.pn * BM + wc * 32 + 8 * fq;
        const float sc = u.pn < 2 ? 0.08838834764831845f : 1.0f;
#pragma unroll
        for (int ai = 0; ai < 2; ++ai)
#pragma unroll
            for (int m = 0; m < 4; ++m) {
                bf16_t* rowp = O + (size_t)(row0 + ai * HALF + m * 16) * 1024 + col0;
#pragma unroll
                for (int bj = 0; bj < 2; ++bj) {
                    const f32x4 v0 = acc[ai][bj][m][0] * sc, v1 = acc[ai][bj][m][1] * sc;
                    u32x4 w; w.x = pk2(v0[0], v0[1]); w.y = pk2(v0[2], v0[3]); w.z = pk2(v1[0], v1[1]); w.w = pk2(v1[2], v1[3]);
                    *(u32x4*)(rowp + bj * HALF) = w;
                }
            }
    }
};
struct EpiRes {
    static constexpr bool PERM = false, AFTER_DRAIN = false;
    const float* resid; float* out; const float* gate;
    __device__ __forceinline__ void operator()(const f32x4 (&acc)[2][2][4][2], const Unit& u, int wr, int wc, int fr, int fq) const {
        const int row0 = u.pm * BM + wr * 64 + fr, col0 = u.pn * BM + wc * 32 + 4 * fq;
        const int b = (u.pm * BM) >> 12;
        f32x4 gv[2][2];
#pragma unroll
        for (int bj = 0; bj < 2; ++bj)
#pragma unroll
            for (int n = 0; n < 2; ++n) gv[bj][n] = *(const f32x4*)(gate + (size_t)b * 6144 + col0 + bj * HALF + n * 16);
#pragma unroll
        for (int ai = 0; ai < 2; ++ai) {
            f32x4 r[4][2][2];
#pragma unroll
            for (int m = 0; m < 4; ++m)
#pragma unroll
                for (int bj = 0; bj < 2; ++bj)
#pragma unroll
                    for (int n = 0; n < 2; ++n) r[m][bj][n] = *(const f32x4*)(resid + (size_t)(row0 + ai * HALF + m * 16) * DM + col0 + bj * HALF + n * 16);
            asm volatile("" ::: "memory");
#pragma unroll
            for (int m = 0; m < 4; ++m)
#pragma unroll
                for (int bj = 0; bj < 2; ++bj)
#pragma unroll
                    for (int n = 0; n < 2; ++n) *(f32x4*)(out + (size_t)(row0 + ai * HALF + m * 16) * DM + col0 + bj * HALF + n * 16) = r[m][bj][n] + gv[bj][n] * acc[ai][bj][m][n];
            asm volatile("" ::: "memory");
        }
    }
};
struct EpiSwiGLU {
    static constexpr bool PERM = true, AFTER_DRAIN = false;
    bf16_t* O;
    __device__ __forceinline__ void operator()(const f32x4 (&acc)[2][2][4][2], const Unit& u, int wr, int wc, int fr, int fq) const {
        const int row0 = u.pm * BM + wr * 64 + fr, col0 = u.pn * HALF + wc * 32 + 8 * fq;
#pragma unroll
        for (int ai = 0; ai < 2; ++ai)
#pragma unroll
            for (int m = 0; m < 4; ++m) {
                bf16_t* rowp = O + (size_t)(row0 + ai * HALF + m * 16) * DFF + col0;
                const f32x4 g0 = acc[ai][0][m][0], g1 = acc[ai][0][m][1];
                const f32x4 t0 = g0 * -1.4426950408889634f, t1 = g1 * -1.4426950408889634f;
                f32x4 e0, e1;
#pragma unroll
                for (int j = 0; j < 4; ++j) { e0[j] = __builtin_amdgcn_exp2f(t0[j]); e1[j] = __builtin_amdgcn_exp2f(t1[j]); }
                const f32x4 d0 = e0 + 1.0f, d1 = e1 + 1.0f;
                f32x4 r0, r1;
#pragma unroll
                for (int j = 0; j < 4; ++j) { r0[j] = __builtin_amdgcn_rcpf(d0[j]); r1[j] = __builtin_amdgcn_rcpf(d1[j]); }
                const f32x4 v0 = (g0 * acc[ai][1][m][0]) * r0, v1 = (g1 * acc[ai][1][m][1]) * r1;
                u32x4 w; w.x = pk2(v0[0], v0[1]); w.y = pk2(v0[2], v0[3]); w.z = pk2(v1[0], v1[1]); w.w = pk2(v1[2], v1[3]);
                *(u32x4*)rowp = w;
            }
    }
};

struct EpiGateBf {
    static constexpr bool PERM = true, AFTER_DRAIN = false;
    bf16_t* O; const float* gate;
    __device__ __forceinline__ void operator()(const f32x4 (&acc)[2][2][4][2], const Unit& u, int wr, int wc, int fr, int fq) const {
        const int row0 = u.pm * BM + wr * 64 + fr, col0 = u.pn * BM + wc * 32 + 8 * fq;
        const int b = (u.pm * BM) >> 12;
        f32x4 gv[2][2];
#pragma unroll
        for (int bj = 0; bj < 2; ++bj)
#pragma unroll
            for (int n = 0; n < 2; ++n) gv[bj][n] = *(const f32x4*)(gate + (size_t)b * 6144 + col0 + bj * HALF + 4 * n);
#pragma unroll
        for (int ai = 0; ai < 2; ++ai)
#pragma unroll
            for (int m = 0; m < 4; ++m) {
                bf16_t* rowp = O + (size_t)(row0 + ai * HALF + m * 16) * DM + col0;
#pragma unroll
                for (int bj = 0; bj < 2; ++bj) {
                    const f32x4 v0 = acc[ai][bj][m][0] * gv[bj][0], v1 = acc[ai][bj][m][1] * gv[bj][1];
                    u32x4 w; w.x = pk2(v0[0], v0[1]); w.y = pk2(v0[2], v0[3]); w.z = pk2(v1[0], v1[1]); w.w = pk2(v1[2], v1[3]);
                    *(u32x4*)(rowp + bj * HALF) = w;
                }
            }
    }
};
template <class Epi, class Sched>
__device__ __forceinline__ void gemm_phase(PG8_LAS unsigned char* lds, const Gemm g, const Sched& S, const Epi& E) {
    const int tid = threadIdx.x, wid = __builtin_amdgcn_readfirstlane(tid >> 6), lane = tid & 63, wr = wid >> 2, wc = wid & 3, fr = lane & 15, fq = lane >> 4;
    const int K = g.K, nt = K / BK;
    unsigned voffA[2], voffB[2];
#pragma unroll
    for (int i = 0; i < 2; ++i) { int R, C; stage_rc(tid * 16 + i * 8192, R, C); const int Rb = Epi::PERM ? ((R & ~31) + perm32(R & 31)) : R;
        voffA[i] = (unsigned)(R * K + C) * 2u; voffB[i] = (unsigned)(Rb * K + C) * 2u; }
    const size_t kstep = (size_t)(BK * 2);
    const size_t hstep = (size_t)HALF * K * 2;
    const size_t tstep = 2 * hstep;
    const unsigned ldsw = (unsigned)wid * 1024u;
    const int aoff = lds_byte(wr * 64 + fr, fq * 8), boff = lds_byte(wc * 32 + fr, fq * 8);
#define PG8_SA(b, h) (((b) * 2 + (h)) * HTB)
#define PG8_SB(b, h) ((4 + (b) * 2 + (h)) * HTB)
#define PG8_STAGE(bufoff, gbase, voff) do { _Pragma("unroll") for (int _i = 0; _i < 2; ++_i) \
        __builtin_amdgcn_global_load_lds((const unsigned*)((const char*)(gbase) + (voff)[_i]), (PG8_LAS unsigned*)(lds + (bufoff) + ldsw + _i * 8192), 16, 0, 0); } while (0)
#define PG8_LDA(dst, b, h) do { _Pragma("unroll") for (int m = 0; m < 4; ++m) _Pragma("unroll") for (int k = 0; k < 2; ++k) dst[m][k] = *(const PG8_LAS bf16x8*)(lds + PG8_SA(b, h) + aoff + m * 2048 + k * 1024); } while (0)
#define PG8_LDB(dst, b, h) do { _Pragma("unroll") for (int n = 0; n < 2; ++n) _Pragma("unroll") for (int k = 0; k < 2; ++k) dst[n][k] = *(const PG8_LAS bf16x8*)(lds + PG8_SB(b, h) + boff + n * 2048 + k * 1024); } while (0)
#define PG8_MMA(ai, bj, At, Bt) do { __builtin_amdgcn_s_setprio(1); _Pragma("unroll") for (int m = 0; m < 4; ++m) _Pragma("unroll") for (int n = 0; n < 2; ++n) _Pragma("unroll") for (int k = 0; k < 2; ++k) \
        acc[ai][bj][m][n] = __builtin_amdgcn_mfma_f32_16x16x32_bf16(Bt[n][k], At[m][k], acc[ai][bj][m][n], 0, 0, 0); __builtin_amdgcn_s_setprio(0); } while (0)
#define PG8_WAIT_V(n) asm volatile("s_waitcnt vmcnt(" #n ")" ::: "memory")
#define PG8_WAIT_L(n) asm volatile("s_waitcnt lgkmcnt(" #n ")" ::: "memory")
#define PG8_BAR __builtin_amdgcn_s_barrier()
#define PG8_SCHED __builtin_amdgcn_sched_barrier(0)
    Unit cur, nxt; int ui = 0;
    if (!S.next(0, cur)) return;
    f32x4 acc[2][2][4][2];
#pragma unroll
    for (int a = 0; a < 2; ++a)
#pragma unroll
        for (int b = 0; b < 2; ++b)
#pragma unroll
            for (int m = 0; m < 4; ++m)
#pragma unroll
                for (int n = 0; n < 2; ++n) acc[a][b][m][n] = (f32x4){0.f, 0.f, 0.f, 0.f};
    bf16x8 At[4][2], B0[2][2], B1[2][2];
    const char* cA = (const char*)g.A + (size_t)cur.pm * tstep; const char* cB = (const char*)g.Bt + (size_t)cur.pn * tstep;
    S.a_ready(cur);
    PG8_STAGE(PG8_SB(0, 0), cB, voffB); PG8_STAGE(PG8_SA(0, 0), cA, voffA); PG8_STAGE(PG8_SB(0, 1), cB + hstep, voffB); PG8_STAGE(PG8_SA(0, 1), cA + hstep, voffA);
    if (wr == 1) PG8_BAR;
    PG8_WAIT_V(4); PG8_BAR;
    PG8_STAGE(PG8_SB(1, 0), cB + kstep, voffB); PG8_STAGE(PG8_SA(1, 0), cA + kstep, voffA); PG8_STAGE(PG8_SB(1, 1), cB + hstep + kstep, voffB);
    PG8_WAIT_V(6); PG8_BAR;
    for (;;) {
        const bool has_next = S.next(ui + 1, nxt);
        const char* nA = has_next ? (const char*)g.A + (size_t)nxt.pm * tstep : cA; const char* nB = has_next ? (const char*)g.Bt + (size_t)nxt.pn * tstep : cB;
        for (int t = 0; t < nt; t += 2) {
            const bool last = (t == nt - 2);
            const char* a1 = cA + (size_t)(t + 1) * kstep;
            const char* a2 = last ? nA : cA + (size_t)(t + 2) * kstep; const char* b2 = last ? nB : cB + (size_t)(t + 2) * kstep;
            const char* a3 = a2 + kstep; const char* b3 = b2 + kstep;
            if (last && has_next) S.a_ready(nxt);
            PG8_LDB(B0, 0, 0); PG8_SCHED; PG8_LDA(At, 0, 0); PG8_STAGE(PG8_SA(1, 1), a1 + hstep, voffA);
            PG8_WAIT_L(8); PG8_BAR; PG8_WAIT_L(0); PG8_MMA(0, 0, At, B0); PG8_BAR; PG8_SCHED;
            PG8_LDB(B1, 0, 1); PG8_STAGE(PG8_SB(0, 0), b2, voffB);
            PG8_BAR; PG8_WAIT_L(0); PG8_MMA(0, 1, At, B1); PG8_BAR;
            PG8_LDA(At, 0, 1); PG8_STAGE(PG8_SA(0, 0), a2, voffA);
            PG8_BAR; PG8_WAIT_L(0); PG8_MMA(1, 0, At, B0); PG8_BAR; PG8_SCHED;
            PG8_STAGE(PG8_SB(0, 1), b2 + hstep, voffB);
            PG8_WAIT_V(6); PG8_BAR; PG8_MMA(1, 1, At, B1); PG8_BAR;
            PG8_LDB(B0, 1, 0); PG8_SCHED; PG8_LDA(At, 1, 0); PG8_STAGE(PG8_SA(0, 1), a2 + hstep, voffA);
            PG8_WAIT_L(8); PG8_BAR; PG8_WAIT_L(0); PG8_MMA(0, 0, At, B0); PG8_BAR; PG8_SCHED;
            PG8_LDB(B1, 1, 1); PG8_STAGE(PG8_SB(1, 0), b3, voffB);
            PG8_BAR; PG8_WAIT_L(0); PG8_MMA(0, 1, At, B1); PG8_BAR;
            PG8_LDA(At, 1, 1); PG8_STAGE(PG8_SA(1, 0), a3, voffA);
            PG8_BAR; PG8_WAIT_L(0); PG8_MMA(1, 0, At, B0); PG8_BAR; PG8_SCHED;
            PG8_STAGE(PG8_SB(1, 1), b3 + hstep, voffB);
            PG8_WAIT_V(6); PG8_BAR; PG8_MMA(1, 1, At, B1); PG8_BAR;
        }
        if constexpr (!Epi::AFTER_DRAIN) { E(acc, cur, wr, wc, fr, fq); S.done(cur); }
        if (!has_next) break;
#pragma unroll
        for (int a = 0; a < 2; ++a)
#pragma unroll
            for (int b = 0; b < 2; ++b)
#pragma unroll
                for (int m = 0; m < 4; ++m)
#pragma unroll
                    for (int n = 0; n < 2; ++n) acc[a][b][m][n] = (f32x4){0.f, 0.f, 0.f, 0.f};
        cur = nxt; cA = nA; cB = nB; ++ui;
    }
    PG8_WAIT_V(0);
    if (wr == 0) PG8_BAR;
    PG8_BAR;
    if constexpr (Epi::AFTER_DRAIN) { E.fused(acc, cur, wr, wc, fr, fq, lds, wid, lane); S.done(cur); }
#undef PG8_SA
#undef PG8_SB
#undef PG8_STAGE
#undef PG8_LDA
#undef PG8_LDB
#undef PG8_MMA
#undef PG8_WAIT_V
#undef PG8_WAIT_L
#undef PG8_BAR
#undef PG8_SCHED
}
}
#define XB_TMO      128
#define XB_XCNT(j)  (256  + 64 * (j))
#define XB_XSUB(j)  (1280 + 64 * (j))
#define XB_XGEN(j)  (2304 + 64 * (j))
#define XB_TOP      3328
#define XB_TOPGEN   3392
#define XCD_BAR_WORDS 3456
#define XB_SPIN_CAP (1u << 18)

__device__ __forceinline__ unsigned xb_ld(unsigned* p)              { return __hip_atomic_load(p, __ATOMIC_RELAXED, __HIP_MEMORY_SCOPE_AGENT); }
__device__ __forceinline__ unsigned xb_add(unsigned* p, unsigned v) { return __hip_atomic_fetch_add(p, v, __ATOMIC_RELAXED, __HIP_MEMORY_SCOPE_AGENT); }
__device__ __forceinline__ unsigned xb_xcc_id() { return (unsigned)__builtin_amdgcn_s_getreg((3 << 11) | 20) & 0xFu; }
#define XB_SPIN(cond, bar) do { unsigned _sp = 0; while (cond) { __builtin_amdgcn_s_sleep(1); \
    if ((++_sp & 255u) == 0u) { if (xb_ld(&(bar)[XB_TMO])) break; if (_sp > XB_SPIN_CAP) { atomicAdd(&(bar)[XB_TMO], 1u); break; } } } } while (0)

struct XcdBarrier {
    unsigned* bar; unsigned x;
    volatile LAS unsigned* st;
};

__device__ __forceinline__ XcdBarrier xcd_barrier_post(unsigned* bar, volatile LAS unsigned* st) {
    XcdBarrier b; b.bar = bar; b.x = xb_xcc_id(); b.st = st;
    if (threadIdx.x == 0) (void)xb_add(&bar[XB_XCNT(b.x)], 1u);
    return b;
}
__device__ __forceinline__ void xcd_barrier_complete(unsigned* bar, unsigned x, unsigned& nloc, unsigned& nx) {
    const unsigned G = gridDim.x * gridDim.y * gridDim.z;
    unsigned sum, cnt, mine, sp = 0u;
    for (;;) {
        sum = 0u; cnt = 0u; mine = 0u;
#pragma unroll
        for (unsigned j = 0; j < 16; ++j) { const unsigned c = xb_ld(&bar[XB_XCNT(j)]); sum += c; cnt += (c > 0u) ? 1u : 0u; mine = (j == x) ? c : mine; }
        if (sum == G) break;
        __builtin_amdgcn_s_sleep(1);
        if ((++sp & 255u) == 0u) { if (xb_ld(&bar[XB_TMO])) break; if (sp > XB_SPIN_CAP) { atomicAdd(&bar[XB_TMO], 1u); break; } }
    }
    nloc = mine > 0u ? mine : 1u; nx = cnt > 0u ? cnt : 1u;
}

__device__ __forceinline__ void xcd_barrier(const XcdBarrier& b) {
    asm volatile("s_waitcnt vmcnt(0)" ::: "memory");
    __syncthreads();
    if (threadIdx.x == 0) {
        unsigned* bar = b.bar;
        __builtin_amdgcn_s_waitcnt(0);
        unsigned nloc = b.st[0], nx = b.st[1];
        if (nloc == 0u) { xcd_barrier_complete(bar, b.x, nloc, nx); b.st[0] = nloc; b.st[1] = nx; }
        const unsigned old = xb_add(&bar[XB_XSUB(b.x)], 1u);
        const unsigned gen = old / nloc;
        if (old + 1u == (gen + 1u) * nloc) {
            __builtin_amdgcn_fence(__ATOMIC_RELEASE, "agent");
            asm volatile("s_waitcnt vmcnt(0)" ::: "memory");
            const unsigned og = xb_add(&bar[XB_TOP], 1u);
            const unsigned tg = og / nx;
            if (og + 1u == (tg + 1u) * nx) xb_add(&bar[XB_TOPGEN], 1u);
            else XB_SPIN(xb_ld(&bar[XB_TOPGEN]) == tg, bar);
            __builtin_amdgcn_fence(__ATOMIC_ACQUIRE, "agent");
            xb_add(&bar[XB_XGEN(b.x)], 1u);
            asm volatile("s_waitcnt vmcnt(0)" ::: "memory");
        } else {
            XB_SPIN(xb_ld(&bar[XB_XGEN(b.x)]) == gen, bar);
            __builtin_amdgcn_fence(__ATOMIC_ACQUIRE, "agent");
            asm volatile("s_waitcnt vmcnt(0)" ::: "memory");
        }
    }
    __syncthreads();
}

DI int src_col(int kind, int n) {
    if (kind == 0) { if (n < 1024) { const int hh = n >> 7, ch = n & 127; return hh * 128 + (ch >> 1) + 64 * (ch & 1); } return n; }
    if (kind == 2) { const int pn = n >> 8, bj = (n >> 7) & 1, i = n & 127; return bj * DFF + 128 * pn + i; }
    return n;
}
struct TrTile { const float* W; bf16_t* Wt; int K, N, kind, n0, k0; };
DI TrTile tr_decode(const Params& p, int i) {
    TrTile t; int tile;
    if (i < (DIN / 64) * (DM / 64)) { t.W = p.in[8]; t.Wt = (bf16_t*)(p.ws + WS_WIN); t.K = DM; t.N = DIN; t.kind = 0; tile = i; }
    else if ((i -= (DIN / 64) * (DM / 64)) < (DM / 64) * (DM / 64)) { t.W = p.in[23]; t.Wt = (bf16_t*)(p.ws + WS_WOUT); t.K = DM; t.N = DM; t.kind = 1; tile = i; }
    else if ((i -= (DM / 64) * (DM / 64)) < (2 * DFF / 64) * (DM / 64)) { t.W = p.in[24]; t.Wt = (bf16_t*)(p.ws + WS_WGU); t.K = DM; t.N = 2 * DFF; t.kind = 2; tile = i; }
    else { i -= (2 * DFF / 64) * (DM / 64); t.W = p.in[25]; t.Wt = (bf16_t*)(p.ws + WS_WDN); t.K = DFF; t.N = DM; t.kind = 3; tile = i; }
    const int ntk = t.K / 64; t.n0 = (tile / ntk) * 64; t.k0 = (tile % ntk) * 64;
    return t;
}
DI void transpose_tiles(unsigned char* lds, const Params& p, int i0, int stride, int n_tiles) {
    const int tid = threadIdx.x;
    float v[8];
#define TR_LOAD(T) do { _Pragma("unroll") for (int e = 0; e < 8; ++e) { const int idx = tid + NTHR * e, kk = idx >> 6, nn = idx & 63; v[e] = (T).W[(size_t)((T).k0 + kk) * (T).N + src_col((T).kind, (T).n0 + nn)]; } } while (0)
    if (i0 >= n_tiles) return;
    TrTile cur = tr_decode(p, i0);
    TR_LOAD(cur);
    int par = 0;
    for (int i = i0; i < n_tiles; i += stride, par ^= 1) {
        bf16_t* T = (bf16_t*)lds + par * (64 * 72);
#pragma unroll
        for (int e = 0; e < 8; ++e) { const int idx = tid + NTHR * e, kk = idx >> 6, nn = idx & 63; T[nn * 72 + kk] = f2bf(v[e]); }
        const TrTile done = cur;
        if (i + stride < n_tiles) { cur = tr_decode(p, i + stride); TR_LOAD(cur); }
        lds_barrier();
        { const int nn = tid >> 3, seg = tid & 7; *(u32x4*)(done.Wt + (size_t)(done.n0 + nn) * done.K + done.k0 + 8 * seg) = *(const u32x4*)(T + nn * 72 + 8 * seg); }
    }
    lds_barrier();
#undef TR_LOAD
}
DI void mod_item(unsigned char* lds, const Params& p, int item) {
    float* S = (float*)lds;
    float* R = S + 9 * 1024;
    const int tid = threadIdx.x;
    for (int i = tid; i < 9 * 1024; i += NTHR) { const float v = i < 8192 ? p.in[1][i] : p.in[3][i - 8192]; S[i] = v / (1.0f + __expf(-v)); }
    __syncthreads();
    const int nn = tid & 63, ks = tid >> 6, n = item * 64 + nn;
    float acc[9];
#pragma unroll
    for (int r = 0; r < 9; ++r) acc[r] = 0.f;
    const float* wm = p.in[4] + n;
#pragma unroll 4
    for (int kk = 0; kk < 128; kk += 4) {
        const int k = ks * 128 + kk;
        const float w0 = wm[(size_t)k * 6144], w1 = wm[(size_t)(k + 1) * 6144], w2 = wm[(size_t)(k + 2) * 6144], w3 = wm[(size_t)(k + 3) * 6144];
#pragma unroll
        for (int r = 0; r < 9; ++r) { const f32x4 sv = *(const f32x4*)(S + r * 1024 + k); acc[r] += sv[0] * w0 + sv[1] * w1 + sv[2] * w2 + sv[3] * w3; }
    }
#pragma unroll
    for (int r = 0; r < 9; ++r) R[(ks * 9 + r) * 64 + nn] = acc[r];
    __syncthreads();
    for (int i = tid; i < 9 * 64; i += NTHR) {
        const int r = i >> 6, c = i & 63; float s = p.in[5][item * 64 + c];
#pragma unroll
        for (int k2 = 0; k2 < 8; ++k2) s += R[(k2 * 9 + r) * 64 + c];
        ((float*)(p.ws + WS_MOD))[r * 6144 + item * 64 + c] = s;
    }
    __syncthreads();
}
DI void filt_item(unsigned char* lds, const Params& p, int item, bool& staged) {
    float* E = (float*)lds;
    float* H1 = E + 8 * 36;
    float* H2 = H1 + 512;
    float* W1 = (float*)(lds + 65536);
    float* W2 = W1 + 33 * 64;
    float* W3 = W2 + 64 * 64;
    const int tid = threadIdx.x, tt = tid >> 6, j = tid & 63, t = item * 8 + tt;
    if (!staged) { staged = true;
        for (int i = tid; i < 33 * 64; i += NTHR) W1[i] = p.in[13][i];
        for (int i = tid; i < 64 * 64; i += NTHR) { W2[i] = p.in[15][i]; W3[i] = p.in[17][i]; } }
    if (j < 33) {
        float v;
        if (j == 0) v = (float)((double)t / 4095.0);
        else {
            const int bi = (j - 1) & 15;
            const double f = (double)(1e-4f) + (double)bi * (((double)15.0f - (double)1e-4f) / 15.0);
            double xr = f * (double)t * (1.0 / 4096.0); xr -= floor(xr);
            const float ang = 6.283185307179586f * (float)xr;
            v = j <= 16 ? cosf(ang) : -sinf(ang);
        }
        E[tt * 36 + j] = v;
    }
    __syncthreads();
    const float fr = p.in[20][j];
    { float a = p.in[14][j];
#pragma unroll
      for (int i = 0; i < 33; ++i) a += E[tt * 36 + i] * W1[i * 64 + j];
      H1[tt * 64 + j] = sinf(fr * a); }
    __syncthreads();
    { float a = p.in[16][j];
#pragma unroll 16
      for (int i = 0; i < 64; ++i) a += H1[tt * 64 + i] * W2[i * 64 + j];
      H2[tt * 64 + j] = sinf(fr * a); }
    __syncthreads();
    { float a = p.in[18][j];
#pragma unroll 16
      for (int i = 0; i < 64; ++i) a += H2[tt * 64 + i] * W3[i * 64 + j];
      ((float*)(p.ws + WS_FH3))[(size_t)t * 64 + j] = sinf(fr * a); }
    __syncthreads();
}
constexpr int T_WIN = (DIN / 64) * (DM / 64), T_WOUT = (DM / 64) * (DM / 64), T_WGU = (2 * DFF / 64) * (DM / 64), T_WDN = (DM / 64) * (DFF / 64);
DI void phase0(unsigned char* lds, const Params& p) {
    const int tid = threadIdx.x;
    { float* rope = (float*)(p.ws + WS_ROPE);
      for (int idx = blockIdx.x * NTHR + tid; idx < SEQ * 64; idx += gridDim.x * NTHR) {
          const int t = idx >> 6, m = idx & 63, row = t >> 6, col = t & 63;
          const float inv = powf(10000.0f, -(float)(m & 31) / 32.0f);
          const float ang = (float)(m < 32 ? row : col) * inv;
          rope[2 * idx] = cosf(ang); rope[2 * idx + 1] = sinf(ang);
      }
      if (blockIdx.x == 0) { for (int i = tid; i < 512 + 1024; i += NTHR) ((float*)(p.ws + WS_KSUM))[i] = 0.f; } }
    bool fw_staged = false;
    if (gridDim.x >= 192) {
        if (blockIdx.x < 96) mod_item(lds, p, blockIdx.x);
        else { const int blk = blockIdx.x - 96, nblk = gridDim.x - 96;
            for (int it = blk; it < 512; it += nblk) filt_item(lds, p, it, fw_staged);
            transpose_tiles(lds, p, blk, nblk, T_WIN); }
        return;
    }
    for (int it = blockIdx.x; it < 96 + 512; it += gridDim.x) {
        if (it < 96) mod_item(lds, p, it); else filt_item(lds, p, it - 96, fw_staged);
    }
    transpose_tiles(lds, p, blockIdx.x, gridDim.x, T_WIN);
}

struct NormRow { f32x4 v[4]; u32x2 ad[4]; };
DI void nrow_load(NormRow& R, const float* s, const bf16_t* ad, int lane) {
#pragma unroll
    for (int k = 0; k < 4; ++k) { const int c = 4 * lane + 256 * k; R.v[k] = *(const f32x4*)(s + c); if (ad) R.ad[k] = *(const u32x2*)(ad + c); }
}
DI void norm_rows(const float* src, const bf16_t* addend, float* xsum, bf16_t* dst, int row_lo, int row_hi, const float* gain, const float* mod, int shift_i, int scale_i, int ctx_row, int blk, int nblk) {
    const bool has_ad = addend != nullptr;
    const int lane = threadIdx.x & 63, w = threadIdx.x >> 6, nw = nblk * 8, wid = blk * 8 + w;
    const int per = (row_hi - row_lo + nw - 1) / nw;
    const int r0 = row_lo + wid * per, r1 = (r0 + per < row_hi) ? r0 + per : row_hi;
    if (r0 >= r1) return;
    f32x4 A[4], Bm[4]; int curb = -1;
    NormRow R[4];
#define NR_LOAD(set, row) nrow_load(R[set], src + (size_t)((row) - row_lo) * DM, has_ad ? addend + (size_t)((row) - row_lo) * DM : nullptr, lane)
#define NR_STEP(u, row) do { if ((row) < r1) { \
        if ((row) + 3 < r1) NR_LOAD(((u) + 3) & 3, (row) + 3); \
        const int b_ = ctx_row >= 0 ? ctx_row : ((row) >> 12); \
        if (b_ != curb) { curb = b_; const float* mr_ = mod + (size_t)b_ * 6144; \
            _Pragma("unroll") for (int k = 0; k < 4; ++k) { const int c = 4 * lane + 256 * k; const f32x4 g_ = *(const f32x4*)(gain + c), sc_ = *(const f32x4*)(mr_ + scale_i * 1024 + c); A[k] = g_ * (sc_ + 1.0f); Bm[k] = *(const f32x4*)(mr_ + shift_i * 1024 + c); } } \
        NormRow& Q = R[u]; \
        if (has_ad) { _Pragma("unroll") for (int k = 0; k < 4; ++k) { Q.v[k] += (f32x4){bflo(Q.ad[k].x), bfhi(Q.ad[k].x), bflo(Q.ad[k].y), bfhi(Q.ad[k].y)}; if (xsum) *(f32x4*)(xsum + (size_t)((row) - row_lo) * DM + 4 * lane + 256 * k) = Q.v[k]; } } \
        float ss = 0.f; \
        _Pragma("unroll") for (int k = 0; k < 4; ++k) ss += Q.v[k][0] * Q.v[k][0] + Q.v[k][1] * Q.v[k][1] + Q.v[k][2] * Q.v[k][2] + Q.v[k][3] * Q.v[k][3]; \
        ss = wave_sum(ss); \
        const float rstd = rsqrtf(ss * (1.0f / DM) + EPSF); \
        _Pragma("unroll") for (int k = 0; k < 4; ++k) { const f32x4 h = Q.v[k] * rstd * A[k] + Bm[k]; u32x2 o; o.x = pk2(h[0], h[1]); o.y = pk2(h[2], h[3]); *(u32x2*)(dst + (size_t)(row) * DM + 4 * lane + 256 * k) = o; } \
    } } while (0)
    NR_LOAD(0, r0); if (r0 + 1 < r1) NR_LOAD(1, r0 + 1); if (r0 + 2 < r1) NR_LOAD(2, r0 + 2);
#pragma unroll 1
    for (int r = r0; r < r1; r += 4) { NR_STEP(0, r); NR_STEP(1, r + 1); NR_STEP(2, r + 2); NR_STEP(3, r + 3); }
#undef NR_LOAD
#undef NR_STEP
}
DI void filt4_item(unsigned char* lds, const Params& p, int item) {
    float* F = (float*)lds;
    const int tid = threadIdx.x, tt = item >> 1, dir = item & 1, t0 = tt * 32, c = tid;
    for (int i = tid; i < 32 * 64; i += NTHR) F[i] = ((const float*)(p.ws + WS_FH3))[(size_t)t0 * 64 + i];
    __syncthreads();
    float w4[64];
#pragma unroll
    for (int j = 0; j < 64; ++j) w4[j] = p.in[19][(size_t)j * 1024 + dir * 512 + c];
    const float mind = logf(0.01f) / 1.5f, maxd = logf(0.01f) / 0.3f;
    const float ad = fabsf(mind + (float)c * ((maxd - mind) / 511.0f));
    float* dst = (float*)(p.ws + WS_KERN) + ((size_t)dir * 512 + c) * SEQ + t0;
    float asum = 0.f;
#pragma unroll 1
    for (int q = 0; q < 8; ++q) {
        f32x4 o;
#pragma unroll
        for (int r = 0; r < 4; ++r) {
            const int tl = q * 4 + r; float a = 0.f;
#pragma unroll
            for (int j = 0; j < 64; j += 4) { const f32x4 fv = *(const f32x4*)(F + tl * 64 + j); a += fv[0] * w4[j] + fv[1] * w4[j + 1] + fv[2] * w4[j + 2] + fv[3] * w4[j + 3]; }
            const float tlin = (float)(t0 + tl) / 4095.0f;
            a *= __expf(-tlin * ad);
            o[r] = a;
            if (!(dir == 1 && t0 + tl == 0)) asum += fabsf(a);
        }
        *(f32x4*)(dst + q * 4) = o;
    }
    atomicAdd((float*)(p.ws + WS_KSUM) + c, asum);
    __syncthreads();
}
struct OneUnit { int pm, pn;
    __device__ bool next(int i, pg8::Unit& u) const { if (i) return false; u.pm = pm; u.pn = pn; return true; }
    __device__ __forceinline__ void a_ready(const pg8::Unit&) const {}
    __device__ __forceinline__ void done(const pg8::Unit&) const {} };
DI void phase1(unsigned char* lds, const Params& p) {
    const float* mod = (const float*)(p.ws + WS_MOD);
    bf16_t* HA = (bf16_t*)(p.ws + WS_HA);
    const bool split = gridDim.x >= 64;
    if (split && blockIdx.x < 32) {
        const int pm = blockIdx.x >> 2, pn = blockIdx.x & 3;
        {
          const int lane = threadIdx.x & 63, w = threadIdx.x >> 6;
          const float* src = p.in[2] + ((size_t)pm * 256 + w * 32) * DM; bf16_t* dst = HA + ((size_t)MTOK + pm * 256 + w * 32) * DM;
          f32x4 A[4], Bm[4];
#pragma unroll
          for (int k = 0; k < 4; ++k) { const int c = 4 * lane + 256 * k; const f32x4 g = *(const f32x4*)(p.in[6] + c), sc = *(const f32x4*)(mod + 8 * 6144 + 1024 + c); A[k] = g * (sc + 1.0f); Bm[k] = *(const f32x4*)(mod + 8 * 6144 + c); }
          f32x4 v[4][4];
#pragma unroll
          for (int r = 0; r < 4; ++r)
#pragma unroll
              for (int k = 0; k < 4; ++k) v[r][k] = *(const f32x4*)(src + (size_t)r * DM + 4 * lane + 256 * k);
#pragma unroll 1
          for (int r0 = 0; r0 < 32; r0 += 4) {
#pragma unroll
              for (int r = 0; r < 4; ++r) {
                  float ss = 0.f;
#pragma unroll
                  for (int k = 0; k < 4; ++k) ss += v[r][k][0] * v[r][k][0] + v[r][k][1] * v[r][k][1] + v[r][k][2] * v[r][k][2] + v[r][k][3] * v[r][k][3];
                  ss = wave_sum(ss);
                  const float rstd = rsqrtf(ss * (1.0f / DM) + EPSF);
                  u32x2 o[4];
#pragma unroll
                  for (int k = 0; k < 4; ++k) { const f32x4 h = v[r][k] * rstd * A[k] + Bm[k]; o[k].x = pk2(h[0], h[1]); o[k].y = pk2(h[2], h[3]); }
                  if (r0 + 4 + r < 32) {
#pragma unroll
                      for (int k = 0; k < 4; ++k) v[r][k] = *(const f32x4*)(src + (size_t)(r0 + 4 + r) * DM + 4 * lane + 256 * k);
                  }
#pragma unroll
                  for (int k = 0; k < 4; ++k) *(u32x2*)(dst + (size_t)(r0 + r) * DM + 4 * lane + 256 * k) = o[k];
              }
          } }
        asm volatile("s_waitcnt vmcnt(0)" ::: "memory");
        __builtin_amdgcn_fence(__ATOMIC_RELEASE, "workgroup"); __syncthreads(); __builtin_amdgcn_fence(__ATOMIC_ACQUIRE, "agent");
        asm volatile("s_waitcnt vmcnt(0)" ::: "memory");
        pg8::Gemm g{HA + (size_t)MTOK * DM, (const bf16_t*)(p.ws + WS_WIN) + (size_t)512 * DM, MCTX, 1024, DM};
        OneUnit S{pm, pn}; pg8::EpiKV E{(bf16_t*)(p.ws + WS_KVC)};
        pg8::gemm_phase<pg8::EpiKV, OneUnit>((LAS unsigned char*)lds, g, S, E);
        return;
    }
    const int blk = split ? blockIdx.x - 32 : blockIdx.x, nblk = split ? gridDim.x - 32 : gridDim.x;
    for (int it = blk; it < 256; it += nblk) filt4_item(lds, p, it);
    norm_rows(p.in[0], nullptr, nullptr, HA, 0, MTOK, p.in[6], mod, 0, 1, -1, blk, nblk);
    if (!split) norm_rows(p.in[2], nullptr, nullptr, HA, MTOK, MTOK + MCTX, p.in[6], mod, 0, 1, 8, blk, nblk);
}

DI void ret_state_item(unsigned char* lds, const Params& p, int item, int variant) {
    const int tid = threadIdx.x, lane = tid & 63, w = tid >> 6;
    const int b = item >> 3, h = (item >> 1) & 3, dir = item & 1, bh = b * 4 + h;
    const bf16_t* P = (const bf16_t*)(p.ws + WS_P);
    const bf16_t* KVC = (const bf16_t*)(p.ws + WS_KVC);
    bf16_t* ST = (bf16_t*)(p.ws + WS_ST);
    constexpr int RS_ROW = 304, RS_IMG = 128 * RS_ROW, RS_BUF = 2 * RS_IMG;
    const float lg = log1pf(-__expf(p.in[9][dir * 4 + h]));
    const float g128 = __expf(lg * 128.0f);
    const int segk = tid & 15, jk0 = tid >> 4;
    float wv[4];
#pragma unroll
    for (int i = 0; i < 4; ++i) { const int j = jk0 + 32 * i; wv[i] = dir == 0 ? __expf(lg * (float)(127 - j)) : __expf(lg * (float)j); }
    u32x4 kreg[2][4], vreg[2][4];
    f32x4 acc[8];
#pragma unroll
    for (int et = 0; et < 8; ++et) acc[et] = (f32x4){0.f, 0.f, 0.f, 0.f};
    const int G = lane >> 4, i16 = lane & 15, q = i16 >> 2, pp = i16 & 3, wd = w >> 2, we = w & 3;
#define RS_LOAD(s, R) do { \
        const bf16_t* kb; size_t ld; \
        if ((s) < 2) { const int cc = dir == 0 ? (s) : 1 - (s); kb = KVC + (size_t)(b * CTXL + cc * 128) * 1024 + h * 128; ld = 1024; } \
        else { const int n = dir == 0 ? (s) - 2 : 31 - ((s) - 2); kb = P + (size_t)(b * SEQ + n * 128) * DIN + 512 + h * 128; ld = DIN; } \
        _Pragma("unroll") for (int i = 0; i < 4; ++i) { kreg[R][i] = *(const u32x4*)(kb + (size_t)(jk0 + 32 * i) * ld + 8 * segk); vreg[R][i] = *(const u32x4*)(kb + 512 + (size_t)(jk0 + 32 * i) * ld + 8 * segk); } } while (0)
#define RS_STEP(s, R, STORE) do { \
        { \
            unsigned char* KI = lds + (R) * RS_BUF; unsigned char* VI = KI + RS_IMG; \
            _Pragma("unroll") for (int i = 0; i < 4; ++i) { \
                *(u32x4*)(KI + (jk0 + 32 * i) * RS_ROW + segk * 16) = kreg[R][i]; \
                const u32x4 vr = vreg[R][i]; const float ww = wv[i]; u32x4 o; o.x = pk2(bflo(vr.x) * ww, bfhi(vr.x) * ww); o.y = pk2(bflo(vr.y) * ww, bfhi(vr.y) * ww); o.z = pk2(bflo(vr.z) * ww, bfhi(vr.z) * ww); o.w = pk2(bflo(vr.w) * ww, bfhi(vr.w) * ww); \
                *(u32x4*)(VI + (jk0 + 32 * i) * RS_ROW + segk * 16) = o; } \
            lds_barrier(); \
            { const int s2_ = (s) + 2 < 33 ? (s) + 2 : 32; RS_LOAD(s2_, R); }        \
            _Pragma("unroll") for (int et = 0; et < 8; ++et) acc[et] *= g128; \
            const LAS unsigned char* kbase = (const LAS unsigned char*)KI; const LAS unsigned char* vbase = (const LAS unsigned char*)VI; \
            _Pragma("unroll") for (int ks = 0; ks < 4; ++ks) {        \
                const int j0 = 32 * ks + 8 * G + q; \
                bf16x8 ak[4], bv[2]; \
                _Pragma("unroll") for (int dt = 0; dt < 4; ++dt) ak[dt] = tr_read8(kbase + j0 * RS_ROW + (64 * wd + 16 * dt + 4 * pp) * 2, 4 * RS_ROW); \
                _Pragma("unroll") for (int et = 0; et < 2; ++et) bv[et] = tr_read8(vbase + j0 * RS_ROW + (32 * we + 16 * et + 4 * pp) * 2, 4 * RS_ROW); \
                _Pragma("unroll") for (int dt = 0; dt < 4; ++dt) \
                _Pragma("unroll") for (int et = 0; et < 2; ++et) acc[dt * 2 + et] = MFMA16(ak[dt], bv[et], acc[dt * 2 + et]); } \
            if (STORE) {        \
                const int n = dir == 0 ? (s) - 1 : 31 - ((s) - 1); \
                  \
                bf16_t* dst = ST + (((size_t)dir * 32 + bh) * 32 + n) * 16384 + (i16 + 16 * (G >> 1)) * 8 + 4 * (G & 1); \
                _Pragma("unroll") for (int dt = 0; dt < 4; ++dt) \
                _Pragma("unroll") for (int et = 0; et < 2; ++et) { const f32x4 a_ = acc[dt * 2 + et]; u32x2 o; o.x = pk2(a_[0], a_[1]); o.y = pk2(a_[2], a_[3]); \
                    *(u32x2*)(dst + (((2 * we + et) * 4 + 2 * wd + (dt >> 1)) * 64 + 32 * (dt & 1)) * 8) = o; } \
            } \
            __builtin_amdgcn_sched_barrier(0);        \
        } } while (0)
    RS_LOAD(0, 0);
    RS_LOAD(1, 1);
    RS_STEP(0, 0, false);
#pragma unroll 1
    for (int s = 1; s < 33; s += 2) { RS_STEP(s, 1, true); RS_STEP(s + 1, 0, true); }
    lds_barrier();
#undef RS_LOAD
#undef RS_STEP
}

DI void unpack8(const u32x4 v, float (&f)[8]) { f[0] = bflo(v.x); f[1] = bfhi(v.x); f[2] = bflo(v.y); f[3] = bfhi(v.y); f[4] = bflo(v.z); f[5] = bfhi(v.z); f[6] = bflo(v.w); f[7] = bfhi(v.w); }
DI void load8f(const float* p, float (&f)[8]) { const f32x4 a = *(const f32x4*)p, b = *(const f32x4*)(p + 4); f[0] = a[0]; f[1] = a[1]; f[2] = a[2]; f[3] = a[3]; f[4] = b[0]; f[5] = b[1]; f[6] = b[2]; f[7] = b[3]; }
DI void hy_u_items(unsigned char* lds, const Params& p, int it0, int stride, int n_items) {
    bf16_t* T = (bf16_t*)lds;
    const int tid = threadIdx.x, row = tid >> 3, seg = tid & 7;
    const bf16_t* Pg = (const bf16_t*)(p.ws + WS_P) + 2048 + 8 * seg;
    const u32x4 z4 = {0u, 0u, 0u, 0u};
    u32x4 xm, x0, xp, vm, v0, vp;
#define HU_LOAD(it) do { const int b_ = (it) >> 9, t_ = (((it) >> 3) & 63) * 64 + row, c0_ = ((it) & 7) * 64; const bf16_t* P_ = Pg + (size_t)b_ * SEQ * DIN + c0_; \
        xm = t_ > 0 ? *(const u32x4*)(P_ + (size_t)(t_ - 1) * DIN + 512) : z4; x0 = *(const u32x4*)(P_ + (size_t)t_ * DIN + 512); xp = t_ < SEQ - 1 ? *(const u32x4*)(P_ + (size_t)(t_ + 1) * DIN + 512) : z4; \
        vm = t_ > 0 ? *(const u32x4*)(P_ + (size_t)(t_ - 1) * DIN + 1024) : z4; v0 = *(const u32x4*)(P_ + (size_t)t_ * DIN + 1024); vp = t_ < SEQ - 1 ? *(const u32x4*)(P_ + (size_t)(t_ + 1) * DIN + 1024) : z4; } while (0)
    if (it0 < n_items) HU_LOAD(it0);
    int par = 0, wct = -1;
    float xw0[8], xw1[8], xw2[8], xbs[8], vw0[8], vw1[8], vw2[8], vbs[8];
    for (int item = it0; item < n_items; item += stride, par ^= 1) {
        const int b = item >> 9, tt = (item >> 3) & 63, ct = item & 7, t0 = tt * 64, c0 = ct * 64;
        if (ct != wct) { wct = ct; const float* sw = p.in[11] + c0 + 8 * seg; const float* sb = p.in[12] + c0 + 8 * seg;
            load8f(sw + 512, xw0); load8f(sw + 1536 + 512, xw1); load8f(sw + 3072 + 512, xw2); load8f(sb + 512, xbs);
            load8f(sw + 1024, vw0); load8f(sw + 1536 + 1024, vw1); load8f(sw + 3072 + 1024, vw2); load8f(sb + 1024, vbs); }
        float u[8];
        { float a[8], bb[8], c[8];
          unpack8(xm, a); unpack8(x0, bb); unpack8(xp, c);
#pragma unroll
          for (int k = 0; k < 8; ++k) u[k] = xbs[k] + xw0[k] * a[k] + xw1[k] * bb[k] + xw2[k] * c[k];
          unpack8(vm, a); unpack8(v0, bb); unpack8(vp, c);
#pragma unroll
          for (int k = 0; k < 8; ++k) u[k] *= vbs[k] + vw0[k] * a[k] + vw1[k] * bb[k] + vw2[k] * c[k]; }
        if (item + stride < n_items) HU_LOAD(item + stride);
        bf16_t* Tb = T + par * (64 * 72);
#pragma unroll
        for (int k = 0; k < 8; k += 2) { const unsigned pk = pk2(u[k], u[k + 1]); Tb[(8 * seg + k) * 72 + (row ^ (8 * seg))] = (bf16_t)(pk & 0xffffu); Tb[(8 * seg + k + 1) * 72 + (row ^ (8 * seg))] = (bf16_t)(pk >> 16); }
        lds_barrier();
        { const int cc = tid >> 3, sg = tid & 7;
          *(u32x4*)((bf16_t*)(p.ws + WS_U) + ((size_t)(c0 + cc) * NB + b) * SEQ + t0 + 8 * sg) = *(const u32x4*)(Tb + cc * 72 + 8 * (sg ^ ((cc >> 3) & 7))); }
    }
    lds_barrier();
#undef HU_LOAD
}

DI void ret_out_items(unsigned char* lds, const Params& p, int it0, int stride, int n_items) {
    const int tid = threadIdx.x, lane = tid & 63, w = tid >> 6;
    const bf16_t* P = (const bf16_t*)(p.ws + WS_P);
    const bf16_t* ST = (const bf16_t*)(p.ws + WS_ST);
    bf16_t* MIX = (bf16_t*)(p.ws + WS_MIXIN);
    constexpr int RO_ROW = 304, RO_IMG = 128 * RO_ROW;
    unsigned char* KB = lds;
    unsigned char* VB = lds + RO_IMG;
    unsigned char* SF = lds + 2 * RO_IMG;
    unsigned char* PI = lds + 2 * RO_IMG + 32768 + w * 5120;
    const int G = lane >> 4, i16 = lane & 15, q = i16 >> 2, pp = i16 & 3;
    const int segk = tid & 15, jk0 = tid >> 4;
    u32x4 kreg[4], vreg[4], sreg[4]; bf16x8 qf[4];
#define RO_LOAD(it) do { const int b_ = (it) >> 7, h_ = ((it) >> 5) & 3, n_ = (it) & 31; const size_t tok_ = (size_t)b_ * SEQ + n_ * 128; \
        const bf16_t* kb_ = P + tok_ * DIN + 512 + h_ * 128; const bf16_t* sf_ = ST + (((size_t)0 * 32 + b_ * 4 + h_) * 32 + n_) * 16384; \
        _Pragma("unroll") for (int i = 0; i < 4; ++i) { const int j_ = jk0 + 32 * i; kreg[i] = *(const u32x4*)(kb_ + (size_t)j_ * DIN + 8 * segk); vreg[i] = *(const u32x4*)(kb_ + 512 + (size_t)j_ * DIN + 8 * segk); \
            sreg[i] = *(const u32x4*)(sf_ + (size_t)(tid + NTHR * i) * 8); } \
        const bf16_t* qb_ = P + (tok_ + 16 * w + i16) * DIN + h_ * 128 + 8 * G; \
        _Pragma("unroll") for (int ks = 0; ks < 4; ++ks) qf[ks] = *(const bf16x8*)(qb_ + 32 * ks); } while (0)
    if (it0 < n_items) RO_LOAD(it0);
  for (int item = it0; item < n_items; item += stride) {
    const int b = item >> 7, h = (item >> 5) & 3, n = item & 31, bh = b * 4 + h;
    const float lgf = log1pf(-__expf(p.in[9][h])), lgb = log1pf(-__expf(p.in[9][4 + h]));
    const float lf2 = lgf * 1.4426950408889634f, lb2 = lgb * 1.4426950408889634f;
    const size_t tok0 = (size_t)b * SEQ + n * 128;
#pragma unroll
    for (int i = 0; i < 4; ++i) {
        const int j = jk0 + 32 * i;
        *(u32x4*)(KB + j * RO_ROW + segk * 16) = kreg[i];
        *(u32x4*)(VB + j * RO_ROW + segk * 16) = vreg[i];
        *(u32x4*)(SF + (tid + NTHR * i) * 16) = sreg[i];
    }
    u32x4 greg[4]; float gnr[8];
    { const bf16_t* gb = P + tok0 * DIN + 1536 + h * 128 + 8 * segk;
#pragma unroll
      for (int i = 0; i < 4; ++i) greg[i] = *(const u32x4*)(gb + (size_t)(jk0 + 32 * i) * DIN);
#pragma unroll
      for (int et = 0; et < 8; ++et) gnr[et] = p.in[10][h * 128 + 16 * et + i16]; }
    lds_barrier();
    int ibase = 16 * w + 4 * G;
    asm volatile("" : "+v"(ibase));
    {
        f32x4 accS[8];
#pragma unroll
        for (int jt = 0; jt < 8; ++jt) {
            accS[jt] = (f32x4){0.f, 0.f, 0.f, 0.f};
#pragma unroll
            for (int ks = 0; ks < 4; ++ks) { const bf16x8 bk = *(const bf16x8*)(KB + (16 * jt + i16) * RO_ROW + (32 * ks + 8 * G) * 2); accS[jt] = MFMA16(qf[ks], bk, accS[jt]); }
            if (jt & 1) __builtin_amdgcn_sched_barrier(0);
        }
#pragma unroll
        for (int jt = 0; jt < 8; ++jt) {
            const int j = 16 * jt + i16; float pv[4];
#pragma unroll
            for (int r = 0; r < 4; ++r) {
                const int diff = ibase + r - j;
                const float ex = __builtin_amdgcn_exp2f((diff > 0 ? lf2 : -lb2) * (float)diff);
                pv[r] = accS[jt][r] * (diff == 0 ? 2.0f : ex);
            }
            u32x2 o; o.x = pk2(pv[0], pv[1]); o.y = pk2(pv[2], pv[3]);
            *(u32x2*)(PI + j * 40 + 8 * G) = o;
        }
    }
    lds_barrier();
    { const bf16_t* sbp = ST + (((size_t)1 * 32 + bh) * 32 + n) * 16384;
#pragma unroll
      for (int i = 0; i < 4; ++i) *(u32x4*)(KB + (tid + NTHR * i) * 16) = *(const u32x4*)(sbp + (size_t)(tid + NTHR * i) * 8); }
    f32x4 accI[8];
    const LAS unsigned char* pbase = (const LAS unsigned char*)PI; const LAS unsigned char* vbase = (const LAS unsigned char*)VB;
#pragma unroll
    for (int et = 0; et < 8; ++et) accI[et] = (f32x4){0.f, 0.f, 0.f, 0.f};
#pragma unroll
    for (int ks = 0; ks < 4; ++ks) {
        const int j0 = 32 * ks + 8 * G + q;
        const bf16x8 ap = tr_read8(pbase + j0 * 40 + 8 * pp, 4 * 40);
#pragma unroll
        for (int et = 0; et < 8; ++et) {
            const bf16x8 bv = tr_read8(vbase + j0 * RO_ROW + (16 * et + 4 * pp) * 2, 4 * RO_ROW);
            accI[et] = MFMA16(ap, bv, accI[et]);
        }
        __builtin_amdgcn_sched_barrier(0);
    }
    float cf[4], cb[4];
#pragma unroll
    for (int r = 0; r < 4; ++r) { const int i = ibase + r; cf[r] = __builtin_amdgcn_exp2f(lf2 * (float)(i + 1)); cb[r] = __builtin_amdgcn_exp2f(lb2 * (float)(128 - i)); }
#pragma unroll
    for (int et = 0; et < 8; ++et) {
        f32x4 accX = (f32x4){0.f, 0.f, 0.f, 0.f};
#pragma unroll
        for (int ks = 0; ks < 4; ++ks) { const bf16x8 bs = *(const bf16x8*)(SF + ((et * 4 + ks) * 64 + lane) * 16); accX = MFMA16(qf[ks], bs, accX); }
#pragma unroll
        for (int r = 0; r < 4; ++r) accI[et][r] += cf[r] * accX[r];
        if (et & 1) __builtin_amdgcn_sched_barrier(0);
    }
    lds_barrier();
    unsigned char* GT = lds + 2 * RO_IMG + 32768;
#pragma unroll
    for (int i = 0; i < 4; ++i) *(u32x4*)(GT + (jk0 + 32 * i) * 272 + segk * 16) = greg[i];
#pragma unroll
    for (int et = 0; et < 8; ++et) {
        f32x4 accX = (f32x4){0.f, 0.f, 0.f, 0.f};
#pragma unroll
        for (int ks = 0; ks < 4; ++ks) { const bf16x8 bs = *(const bf16x8*)(KB + ((et * 4 + ks) * 64 + lane) * 16); accX = MFMA16(qf[ks], bs, accX); }
#pragma unroll
        for (int r = 0; r < 4; ++r) accI[et][r] += cb[r] * accX[r];
        if (et & 1) __builtin_amdgcn_sched_barrier(0);
    }
    if (item + stride < n_items) RO_LOAD(item + stride);
    lds_barrier();
#pragma unroll
    for (int r = 0; r < 4; ++r) {
        float s = 0.f;
#pragma unroll
        for (int et = 0; et < 8; ++et) s += accI[et][r];
        s += __shfl_xor(s, 1); s += __shfl_xor(s, 2); s += __shfl_xor(s, 4); s += __shfl_xor(s, 8);
        const float mu = s * (1.0f / 128.0f);
        float v = 0.f;
#pragma unroll
        for (int et = 0; et < 8; ++et) { const float d = accI[et][r] - mu; v += d * d; }
        v += __shfl_xor(v, 1); v += __shfl_xor(v, 2); v += __shfl_xor(v, 4); v += __shfl_xor(v, 8);
        const float rstd = rsqrtf(v * (1.0f / 128.0f) + EPSF);
        bf16_t* grow = (bf16_t*)(GT + (16 * w + 4 * G + r) * 272) + i16;
#pragma unroll
        for (int et = 0; et < 8; ++et) {
            const float g = bf2f(grow[16 * et]);
            grow[16 * et] = f2bf((accI[et][r] - mu) * rstd * gnr[et] * (g * __builtin_amdgcn_rcpf(1.0f + __builtin_amdgcn_exp2f(-1.4426950408889634f * g))));
        }
    }
    lds_barrier();
#pragma unroll
    for (int i = 0; i < 4; ++i) { const int j = jk0 + 32 * i; *(u32x4*)(MIX + (tok0 + j) * DM + h * 128 + 8 * segk) = *(const u32x4*)(GT + j * 272 + segk * 16); }
    lds_barrier();
  }
#undef RO_LOAD
}

constexpr int KR_OFF = 4112, KR_N = 8208, KR_BYTES = 16640, USH_ROW = 1040, USH_BYTES = 64 * USH_ROW;
DI void conv_item(unsigned char* lds, const Params& p, int c) {
    const int tid = threadIdx.x, lane = tid & 63, w = tid >> 6;
    bf16_t* KR = (bf16_t*)lds;
    unsigned char* USH = lds + KR_BYTES;
    const bf16_t* Ug = (const bf16_t*)(p.ws + WS_U) + (size_t)c * NB * SEQ;
    bf16_t* Yg = (bf16_t*)(p.ws + WS_YC) + (size_t)c * NB * SEQ;
    { const float* kf = (const float*)(p.ws + WS_KERN) + (size_t)c * SEQ; const float* kb = kf + (size_t)512 * SEQ;
      const float sc = 1.0f / (((const float*)(p.ws + WS_KSUM))[c] + EPSF);
      float kv[17];
#pragma unroll
      for (int k = 0; k < 17; ++k) {
          const int y = tid + NTHR * k, m = KR_OFF - y, am = m < 0 ? -m : m, ai = am < SEQ ? am : SEQ - 1;
          kv[k] = (m >= 0 ? kf : kb)[ai];
          if (am >= SEQ) kv[k] = 0.f;
      }
#pragma unroll
      for (int k = 0; k < 17; ++k) { const int y = tid + NTHR * k; if (y < KR_N + 8) KR[y] = f2bf(kv[k] * sc); } }
    const int rh = tid >> 8, sb = (tid >> 5) & 7, sg = tid & 31;
    u32x4 lo[2], hi[2];
#define CV_LOAD(qc) do { _Pragma("unroll") for (int h2 = 0; h2 < 2; ++h2) { const int e0 = -16 + 512 * (qc) + 256 * h2 + 8 * sg, e1 = e0 + 8; \
        lo[h2] = (e0 >= 0 && e0 < SEQ) ? *(const u32x4*)(Ug + (size_t)sb * SEQ + e0) : (u32x4){0u, 0u, 0u, 0u}; \
        hi[h2] = (e1 >= 0 && e1 < SEQ) ? *(const u32x4*)(Ug + (size_t)sb * SEQ + e1) : (u32x4){0u, 0u, 0u, 0u}; } } while (0)
#define CV_WIN(r, dst, h2) do { const unsigned wv[8] = {lo[h2].x, lo[h2].y, lo[h2].z, lo[h2].w, hi[h2].x, hi[h2].y, hi[h2].z, hi[h2].w}; constexpr int e_ = (r) >> 1; u32x4 o_; \
        if ((r) & 1) { o_.x = (wv[e_] >> 16) | (wv[e_ + 1] << 16); o_.y = (wv[e_ + 1] >> 16) | (wv[e_ + 2] << 16); o_.z = (wv[e_ + 2] >> 16) | (wv[e_ + 3] << 16); o_.w = (wv[e_ + 3] >> 16) | (wv[e_ + 4] << 16); } \
        else { o_.x = wv[e_]; o_.y = wv[e_ + 1]; o_.z = wv[e_ + 2]; o_.w = wv[e_ + 3]; } \
        *(u32x4*)((dst) + (sb * 8 + (r)) * USH_ROW + (h2) * 512 + sg * 16) = o_; } while (0)
#define CV_STORE(buf) do { unsigned char* d_ = USH + (buf) * USH_BYTES; \
        if (rh == 0) { CV_WIN(0, d_, 0); CV_WIN(1, d_, 0); CV_WIN(2, d_, 0); CV_WIN(3, d_, 0); CV_WIN(0, d_, 1); CV_WIN(1, d_, 1); CV_WIN(2, d_, 1); CV_WIN(3, d_, 1); } \
        else { CV_WIN(4, d_, 0); CV_WIN(5, d_, 0); CV_WIN(6, d_, 0); CV_WIN(7, d_, 0); CV_WIN(4, d_, 1); CV_WIN(5, d_, 1); CV_WIN(6, d_, 1); CV_WIN(7, d_, 1); } } while (0)
    f32x16 acc[2][2];
#pragma unroll
    for (int a = 0; a < 2; ++a)
#pragma unroll
        for (int b2 = 0; b2 < 2; ++b2)
#pragma unroll
            for (int k = 0; k < 16; ++k) acc[a][b2][k] = 0.f;
    const int i32 = lane & 31, hh = lane >> 5;
    const int ya0 = KR_OFF - 256 * (2 * w) - 8 * i32 - 16 + 8 * hh, ya1 = ya0 - 256;
    const int brow0 = i32 * USH_ROW + hh * 16, brow1 = brow0 + 32 * USH_ROW;
    CV_LOAD(0);
    CV_STORE(0);
    CV_LOAD(1);
    lds_barrier();
#define CV_FRAGS(st_, A0, A1, B0, B1) do { const int sg16_ = (qc * 32 + hf * 16 + (st_)) * 16; \
        A0 = *(const bf16x8*)(KR + ya0 + sg16_); A1 = *(const bf16x8*)(KR + ya1 + sg16_); \
        B0 = *(const bf16x8*)(ub + brow0 + (hf * 16 + (st_)) * 32); B1 = *(const bf16x8*)(ub + brow1 + (hf * 16 + (st_)) * 32); } while (0)
#define CV_MMA(A0, A1, B0, B1) do { acc[0][0] = MFMA32(A0, B0, acc[0][0]); acc[0][1] = MFMA32(A0, B1, acc[0][1]); acc[1][0] = MFMA32(A1, B0, acc[1][0]); acc[1][1] = MFMA32(A1, B1, acc[1][1]); } while (0)
#pragma unroll 1
    for (int qc = 0; qc < 9; ++qc) {
        if (qc + 1 < 9) CV_STORE((qc + 1) & 1);
        if (qc + 2 < 9) CV_LOAD(qc + 2);
        const unsigned char* ub = USH + (qc & 1) * USH_BYTES;
        bf16x8 fa0, fa1, fb0, fb1, ga0, ga1, gb0, gb1;
        if (qc < 8) {
#pragma unroll 1
            for (int hf = 0; hf < 2; ++hf) {
                CV_FRAGS(0, fa0, fa1, fb0, fb1);
#pragma unroll
                for (int st = 0; st < 16; st += 2) {
                    CV_FRAGS(st + 1, ga0, ga1, gb0, gb1);
                    CV_MMA(fa0, fa1, fb0, fb1);
                    if (st + 2 < 16) CV_FRAGS(st + 2, fa0, fa1, fb0, fb1);
                    CV_MMA(ga0, ga1, gb0, gb1);
                }
            }
        } else { const int hf = 0; CV_FRAGS(0, fa0, fa1, fb0, fb1); CV_MMA(fa0, fa1, fb0, fb1); }
        lds_barrier();
    }
#undef CV_FRAGS
#undef CV_MMA
#pragma unroll
    for (int mi = 0; mi < 2; ++mi)
#pragma unroll
        for (int nt = 0; nt < 2; ++nt)
#pragma unroll
            for (int reg = 0; reg < 16; reg += 2) {
                const int i = (reg & 3) + 8 * (reg >> 2) + 4 * hh, bb = 4 * nt + (i32 >> 3), r = i32 & 7;
                const unsigned pk = pk2(acc[mi][nt][reg], acc[mi][nt][reg + 1]);
                bf16_t* yp = Yg + (size_t)bb * SEQ + 256 * (2 * w + mi) + 8 * i + r;
                yp[0] = (bf16_t)(pk & 0xffffu); yp[8] = (bf16_t)(pk >> 16);
            }
    lds_barrier();
#undef CV_LOAD
#undef CV_WIN
#undef CV_STORE
}

DI void hy_fin_item(unsigned char* lds, const Params& p, int item) {
    float* Z = (float*)lds;
    const int tid = threadIdx.x, lane = tid & 63, w = tid >> 6;
    const int b = item >> 6, t0 = (item & 63) * 64;
    { const int c = tid; const float bias = p.in[21][c];
      const bf16_t* yc = (const bf16_t*)(p.ws + WS_YC) + ((size_t)c * NB + b) * SEQ + t0;
      const bf16_t* uu = (const bf16_t*)(p.ws + WS_U) + ((size_t)c * NB + b) * SEQ + t0;
#pragma unroll 8
      for (int seg = 0; seg < 8; ++seg) {
          const u32x4 yv = *(const u32x4*)(yc + 8 * seg), uv = *(const u32x4*)(uu + 8 * seg);
          const unsigned ya[4] = {yv.x, yv.y, yv.z, yv.w}, ua[4] = {uv.x, uv.y, uv.z, uv.w};
#pragma unroll
          for (int k = 0; k < 4; ++k) {
              Z[(8 * seg + 2 * k) * 516 + c] = bflo(ya[k]) + bflo(ua[k]) * bias;
              Z[(8 * seg + 2 * k + 1) * 516 + c] = bfhi(ya[k]) + bfhi(ua[k]) * bias;
          }
      } }
    lds_barrier();
    const bf16_t* P = (const bf16_t*)(p.ws + WS_P) + (size_t)b * SEQ * DIN + 2048 + 8 * lane;
    bf16_t* MIX = (bf16_t*)(p.ws + WS_MIXIN) + (size_t)b * SEQ * DM + 512 + 8 * lane;
    float w0[8], w1[8], w2[8], bs[8], og[8];
    load8f(p.in[11] + 8 * lane, w0); load8f(p.in[11] + 1536 + 8 * lane, w1); load8f(p.in[11] + 3072 + 8 * lane, w2); load8f(p.in[12] + 8 * lane, bs); load8f(p.in[22] + 8 * lane, og);
    const int ts = t0 + 8 * w;
    u32x4 rows[10];
#pragma unroll
    for (int r = 0; r < 10; ++r) { const int t = ts - 1 + r; rows[r] = (t >= 0 && t < SEQ) ? *(const u32x4*)(P + (size_t)t * DIN) : (u32x4){0u, 0u, 0u, 0u}; }
#pragma unroll
    for (int tt = 0; tt < 8; ++tt) {
        const int tl = 8 * w + tt;
        float am[8], a0[8], ap[8], z[8], y[8];
        unpack8(rows[tt], am); unpack8(rows[tt + 1], a0); unpack8(rows[tt + 2], ap);
        load8f(Z + tl * 516 + 8 * lane, z);
        float ss = 0.f;
#pragma unroll
        for (int k = 0; k < 8; ++k) { y[k] = (bs[k] + w0[k] * am[k] + w1[k] * a0[k] + w2[k] * ap[k]) * z[k]; ss += y[k] * y[k]; }
        ss = wave_sum(ss);
        const float rstd = rsqrtf(ss * (1.0f / 512.0f) + EPSF);
        u32x4 o; o.x = pk2(y[0] * rstd * og[0], y[1] * rstd * og[1]); o.y = pk2(y[2] * rstd * og[2], y[3] * rstd * og[3]); o.z = pk2(y[4] * rstd * og[4], y[5] * rstd * og[5]); o.w = pk2(y[6] * rstd * og[6], y[7] * rstd * og[7]);
        *(u32x4*)(MIX + (size_t)(ts + tt) * DM) = o;
    }
    lds_barrier();
}

struct FinRow { f32x4 v[4]; u32x2 a[4], b[4]; };
DI void frow_load(FinRow& R, const float* x, const bf16_t* a, const bf16_t* b, int lane) {
#pragma unroll
    for (int k = 0; k < 4; ++k) { const int c = 4 * lane + 256 * k; R.v[k] = __builtin_nontemporal_load((const f32x4*)(x + c)); R.a[k] = __builtin_nontemporal_load((const u32x2*)(a + c)); R.b[k] = __builtin_nontemporal_load((const u32x2*)(b + c)); }
}
DI void final_norm_rows(const float* x, const bf16_t* mg, const bf16_t* fg, float* out, const float* gain) {
    const int xb = (gridDim.x & 7) ? (int)blockIdx.x : (int)((blockIdx.x & 7) * (gridDim.x >> 3) + (blockIdx.x >> 3));
    const int lane = threadIdx.x & 63, w = threadIdx.x >> 6, nw = gridDim.x * 8, wid = xb * 8 + w;
    const int per = (MTOK + nw - 1) / nw, r0 = wid * per, r1 = (r0 + per < MTOK) ? r0 + per : MTOK;
    if (r0 >= r1) return;
    f32x4 g[4];
#pragma unroll
    for (int k = 0; k < 4; ++k) g[k] = *(const f32x4*)(gain + 4 * lane + 256 * k);
    FinRow R[4];
#define FN_LOAD(set, row) frow_load(R[set], x + (size_t)(row) * DM, mg + (size_t)(row) * DM, fg + (size_t)(row) * DM, lane)
#define FN_STEP(u, row) do { if ((row) < r1) { \
        if ((row) + 3 < r1) FN_LOAD(((u) + 3) & 3, (row) + 3); \
        FinRow& Q = R[u]; float ss = 0.f; \
        _Pragma("unroll") for (int k = 0; k < 4; ++k) { Q.v[k] += (f32x4){bflo(Q.a[k].x), bfhi(Q.a[k].x), bflo(Q.a[k].y), bfhi(Q.a[k].y)}; Q.v[k] += (f32x4){bflo(Q.b[k].x), bfhi(Q.b[k].x), bflo(Q.b[k].y), bfhi(Q.b[k].y)}; \
            ss += Q.v[k][0] * Q.v[k][0] + Q.v[k][1] * Q.v[k][1] + Q.v[k][2] * Q.v[k][2] + Q.v[k][3] * Q.v[k][3]; } \
        ss = wave_sum(ss); \
        const float rstd = rsqrtf(ss * (1.0f / DM) + EPSF); \
        _Pragma("unroll") for (int k = 0; k < 4; ++k) *(f32x4*)(out + (size_t)(row) * DM + 4 * lane + 256 * k) = Q.v[k] * rstd * g[k]; \
    } } while (0)
    FN_LOAD(0, r0); if (r0 + 1 < r1) FN_LOAD(1, r0 + 1); if (r0 + 2 < r1) FN_LOAD(2, r0 + 2);
#pragma unroll 1
    for (int r = r0; r < r1; r += 4) { FN_STEP(0, r); FN_STEP(1, r + 1); FN_STEP(2, r + 2); FN_STEP(3, r + 3); }
#undef FN_LOAD
#undef FN_STEP
}

#ifndef PROBE_VARIANT
#define PROBE_VARIANT 0
#endif
#ifndef PROBE_PH
#define PROBE_PH -1
#endif
constexpr int NPH = 13;
constexpr unsigned SYNC_AFTER = 0x0FD7u;
__global__ void __launch_bounds__(NTHR, 2) fwd_kernel(Params p, int ph_lo, int ph_hi, int variant) {
    extern __shared__ __attribute__((aligned(16))) unsigned char lds[];
    cg::grid_group grid = cg::this_grid();
    LAS unsigned char* lds3 = (LAS unsigned char*)lds;
    volatile LAS unsigned* bst = (volatile LAS unsigned*)(lds3 + LDS_BYTES - 16);
    if (threadIdx.x < 4) bst[threadIdx.x] = 0u;
    __syncthreads();
    XcdBarrier xbar = xcd_barrier_post((unsigned*)(p.ws + WS_BAR), bst);
    if (ph_hi < 0) grid.sync();
    unsigned char* ws = p.ws;
    const float* MOD = (const float*)(ws + WS_MOD);
    const int xblk = (gridDim.x & 7) ? (int)blockIdx.x : (int)((blockIdx.x & 7) * (gridDim.x >> 3) + (blockIdx.x >> 3));
#ifndef ONLYPH
#define ONLYPH -1
#endif
#define RUN(k) ((ONLYPH < 0 || ONLYPH == (k)) && ph_lo <= (k) && (k) < ph_hi)
#define SEAM(k) do { if (((SYNC_AFTER >> (k)) & 1u) && RUN(k) && (k) + 1 < ph_hi) xcd_barrier(xbar); } while (0)
    if (RUN(0)) phase0(lds, p);
    SEAM(0);
    if (RUN(1)) phase1(lds, p);
    SEAM(1);
    if (RUN(2)) {
        { pg8::Gemm g{(const bf16_t*)(ws + WS_HA), (const bf16_t*)(ws + WS_WIN), MTOK, DIN, DM}; pg8::StaticOrder S; S.init(MTOK, DIN, gridDim.x, blockIdx.x);
          pg8::EpiP E{(bf16_t*)(ws + WS_P), (const float*)(ws + WS_ROPE)};
          pg8::gemm_phase<pg8::EpiP, pg8::StaticOrder>(lds3, g, S, E); }
        if (gridDim.x < 64) { pg8::Gemm g{(const bf16_t*)(ws + WS_HA) + (size_t)MTOK * DM, (const bf16_t*)(ws + WS_WIN) + (size_t)512 * DM, MCTX, 1024, DM}; pg8::StaticOrder S; S.init(MCTX, 1024, gridDim.x, blockIdx.x);
          pg8::EpiKV E{(bf16_t*)(ws + WS_KVC)};
          pg8::gemm_phase<pg8::EpiKV, pg8::StaticOrder>(lds3, g, S, E); }
    }
    SEAM(2);
    const bool split34 = RUN(3) && RUN(4) && gridDim.x >= 128;
    if (RUN(3)) { if (split34) { if (blockIdx.x < 64) ret_state_item(lds, p, blockIdx.x, variant); } else for (int it = blockIdx.x; it < 64; it += gridDim.x) ret_state_item(lds, p, it, variant); }
    SEAM(3);
    if (RUN(4)) {
        constexpr int T_ALL = T_WIN + T_WOUT + T_WGU + T_WDN;
        if (split34) { if (blockIdx.x >= 64) { hy_u_items(lds, p, blockIdx.x - 64, gridDim.x - 64, 4096); transpose_tiles(lds, p, T_WIN + blockIdx.x - 64, gridDim.x - 64, T_ALL); } }
        else { hy_u_items(lds, p, blockIdx.x, gridDim.x, 4096); transpose_tiles(lds, p, T_WIN + blockIdx.x, gridDim.x, T_ALL); }
    }
    SEAM(4);
    if (RUN(6)) { if (gridDim.x == 256) ret_out_items(lds, p, (blockIdx.x & 7) * 128 + (blockIdx.x >> 3), 32, (blockIdx.x & 7) * 128 + 128);
                  else ret_out_items(lds, p, blockIdx.x, gridDim.x, 1024); }
    if (RUN(5)) { for (int it = blockIdx.x; it < 512; it += gridDim.x) conv_item(lds, p, it); }
    SEAM(6);
    if (RUN(7)) { if (gridDim.x == 256) { for (int kk = 0; kk < 2; ++kk) hy_fin_item(lds, p, (blockIdx.x & 7) * 64 + (blockIdx.x >> 3) + 32 * kk); }
                  else for (int it = blockIdx.x; it < 512; it += gridDim.x) hy_fin_item(lds, p, it); }
    SEAM(7);
    if (RUN(8)) {
        pg8::Gemm g{(const bf16_t*)(ws + WS_MIXIN), (const bf16_t*)(ws + WS_WOUT), MTOK, DM, DM}; pg8::StaticOrder S; S.init(MTOK, DM, gridDim.x, blockIdx.x);
        pg8::EpiGateBf E{(bf16_t*)(ws + WS_MG), MOD + 2 * 1024};
        pg8::gemm_phase<pg8::EpiGateBf, pg8::StaticOrder>(lds3, g, S, E);
    }
    SEAM(8);
    if (RUN(9)) norm_rows(p.in[0], (const bf16_t*)(ws + WS_MG), nullptr, (bf16_t*)(ws + WS_H2), 0, MTOK, p.in[7], MOD, 3, 4, -1, xblk, gridDim.x);
    SEAM(9);
    if (RUN(10)) {
        pg8::Gemm g{(const bf16_t*)(ws + WS_H2), (const bf16_t*)(ws + WS_WGU), MTOK, 2 * DFF, DM}; pg8::StaticOrder S; S.init(MTOK, 2 * DFF, gridDim.x, blockIdx.x);
        pg8::EpiSwiGLU E{(bf16_t*)(ws + WS_ACT)};
        pg8::gemm_phase<pg8::EpiSwiGLU, pg8::StaticOrder>(lds3, g, S, E);
    }
    SEAM(10);
    if (RUN(11)) {
        pg8::Gemm g{(const bf16_t*)(ws + WS_ACT), (const bf16_t*)(ws + WS_WDN), MTOK, DM, DFF}; pg8::StaticOrder S; S.init(MTOK, DM, gridDim.x, blockIdx.x);
        pg8::EpiGateBf E{(bf16_t*)(ws + WS_FG), MOD + 5 * 1024};
        pg8::gemm_phase<pg8::EpiGateBf, pg8::StaticOrder>(lds3, g, S, E);
    }
    SEAM(11);
    if (RUN(12)) final_norm_rows(p.in[0], (const bf16_t*)(ws + WS_MG), (const bf16_t*)(ws + WS_FG), p.out, p.in[26]);
#undef RUN
#undef SEAM
}

extern "C" void kernel_launch(void* const* d_in, const int* in_sizes, int n_in, void* d_out, int out_size, void* d_ws, size_t ws_size, hipStream_t stream) {
    static int grid = 0;
    if (grid == 0) {
        if (n_in != 27 || ws_size < WS_END) { fprintf(stderr, "kernel_launch: unexpected n_in %d or ws_size %zu (< %zu)\n", n_in, ws_size, (size_t)WS_END); grid = -1; return; }
        int dev = 0, cus = 0, per_cu = 0;
        hipGetDevice(&dev);
        hipDeviceGetAttribute(&cus, hipDeviceAttributeMultiprocessorCount, dev);
        if (hipFuncSetAttribute((const void*)fwd_kernel, hipFuncAttributeMaxDynamicSharedMemorySize, LDS_BYTES) != hipSuccess) { fprintf(stderr, "kernel_launch: hipFuncSetAttribute failed\n"); grid = -1; return; }
        hipOccupancyMaxActiveBlocksPerMultiprocessor(&per_cu, (const void*)fwd_kernel, NTHR, LDS_BYTES);
        if (per_cu < 1) { fprintf(stderr, "kernel_launch: occupancy query says %d blocks per CU\n", per_cu); per_cu = 1; }
        (void)hipGetLastError();
        grid = cus * 1;
    }
    if (grid < 0) return;
    Params p{};
    for (int i = 0; i < 27; ++i) p.in[i] = (const float*)d_in[i];
    p.out = (float*)d_out; p.ws = (unsigned char*)d_ws;
#if defined(MULTI_LAUNCH)
    for (int k = 0; k < NPH; ++k) { int lo = k, hi = k + 1; (void)hipMemsetAsync((unsigned char*)d_ws + WS_BAR, 0, XCD_BAR_WORDS * 4, stream); hipLaunchKernelGGL(fwd_kernel, dim3(grid), dim3(NTHR), LDS_BYTES, stream, p, lo, hi, 0); }
#else
    const int nl = PROBE_PH >= 0 ? 2 : 1;
    for (int li = 0; li < nl; ++li) {
        int lo = (PROBE_PH >= 0 && li == 1) ? PROBE_PH : 0, hi = (PROBE_PH >= 0 && li == 0) ? PROBE_PH + 1 : NPH;
        int var = (PROBE_PH >= 0 && li == 0) ? PROBE_VARIANT : 0;
        (void)hipMemsetAsync((unsigned char*)d_ws + WS_BAR, 0, XCD_BAR_WORDS * 4, stream);
        void* args[] = {&p, &lo, &hi, &var};
        hipError_t e = hipLaunchCooperativeKernel((const void*)fwd_kernel, dim3(grid), dim3(NTHR), args, LDS_BYTES, stream);
        if (e != hipSuccess) fprintf(stderr, "cooperative launch failed: %s (grid %d)\n", hipGetErrorString(e), grid);
    }
#endif
}
```

```cpp
#include <hip/hip_runtime.h>
#include <hip/hip_cooperative_groups.h>
#include <cstdio>
namespace cg = cooperative_groups;

#define DI __device__ __forceinline__
#define LAS __attribute__((address_space(3)))
#define PG8_LAS __attribute__((address_space(3)))
typedef unsigned short bf16_t;
typedef short bf16x8 __attribute__((ext_vector_type(8)));
typedef short s16x4 __attribute__((ext_vector_type(4)));
typedef float f32x4 __attribute__((ext_vector_type(4)));
typedef float f32x16 __attribute__((ext_vector_type(16)));
typedef unsigned u32x4 __attribute__((ext_vector_type(4)));
typedef unsigned u32x2 __attribute__((ext_vector_type(2)));

constexpr int NB = 8, SEQ = 4096, DM = 1024, MTOK = NB * SEQ, CTXL = 256, MCTX = NB * CTXL;
constexpr int DIN = 3584, DFF = 2816, NH = 4, DHD = 128, NMOD = 6;
constexpr float EPSF = 1e-6f;
constexpr int NTHR = 512;
constexpr int LDS_BYTES = 160 * 1024;

constexpr size_t WS_WIN = 0;
constexpr size_t WS_WOUT = WS_WIN + (size_t)DIN * DM * 2;
constexpr size_t WS_WGU = WS_WOUT + (size_t)DM * DM * 2;
constexpr size_t WS_WDN = WS_WGU + (size_t)2 * DFF * DM * 2;
constexpr size_t WS_MOD = WS_WDN + (size_t)DM * DFF * 2;
constexpr size_t WS_ROPE = WS_MOD + (size_t)9 * 6144 * 4;
constexpr size_t WS_FH3 = WS_ROPE + (size_t)SEQ * 64 * 2 * 4;
constexpr size_t WS_KERN = WS_FH3 + (size_t)SEQ * 64 * 4;
constexpr size_t WS_KSUM = WS_KERN + (size_t)2 * 512 * SEQ * 4;
constexpr size_t WS_MISC = WS_KSUM + 2048;
constexpr size_t WS_BAR = WS_MISC + 4096 + 2048;
constexpr size_t WS_KVC = WS_BAR + 16384;
constexpr size_t WS_HA = WS_KVC + (size_t)MCTX * 1024 * 2;
constexpr size_t WS_P = WS_HA + (size_t)(MTOK + MCTX) * DM * 2;
constexpr size_t WS_ST = WS_P + (size_t)MTOK * DIN * 2;
constexpr size_t WS_U = WS_ST + (size_t)2 * 32 * 32 * 16384 * 2;
constexpr size_t WS_YC = WS_U + (size_t)512 * NB * SEQ * 2;
constexpr size_t WS_END = WS_YC + (size_t)512 * NB * SEQ * 2;
constexpr size_t WS_MIXIN = WS_HA, WS_H2 = WS_HA, WS_ACT = WS_P;
constexpr size_t WS_MG = WS_ST, WS_FG = WS_HA;

struct Params { const float* in[27]; float* out; unsigned char* ws; };

DI unsigned short f2bf(float f) { unsigned u = __float_as_uint(f); u += 0x7FFFu + ((u >> 16) & 1u); return (unsigned short)(u >> 16); }
DI float bf2f(unsigned short b) { return __uint_as_float(((unsigned)b) << 16); }
typedef __bf16 bf16x2_t __attribute__((ext_vector_type(2)));
typedef float f32x2_t __attribute__((ext_vector_type(2)));
DI unsigned pk2(float lo, float hi) { const f32x2_t v = {lo, hi}; const bf16x2_t r = __builtin_convertvector(v, bf16x2_t); return __builtin_bit_cast(unsigned, r); }
DI float bflo(unsigned w) { return __uint_as_float(w << 16); }
DI float bfhi(unsigned w) { return __uint_as_float(w & 0xffff0000u); }
DI float wave_sum(float v) {
#pragma unroll
    for (int o = 32; o > 0; o >>= 1) v += __shfl_xor(v, o);
    return v;
}
DI float sigmoidf_(float x) { return __builtin_amdgcn_rcpf(1.0f + __builtin_amdgcn_exp2f(-1.4426950408889634f * x)); }
#define MFMA16(a, b, c) __builtin_amdgcn_mfma_f32_16x16x32_bf16((a), (b), (c), 0, 0, 0)
#define MFMA32(a, b, c) __builtin_amdgcn_mfma_f32_32x32x16_bf16((a), (b), (c), 0, 0, 0)

DI bf16x8 tr_read8(const LAS unsigned char* p, int hi_off) {
    const s16x4 lo = __builtin_amdgcn_ds_read_tr16_b64_v4i16((LAS s16x4*)p);
    const s16x4 hi = __builtin_amdgcn_ds_read_tr16_b64_v4i16((LAS s16x4*)(p + hi_off));
    return __builtin_shufflevector(lo, hi, 0, 1, 2, 3, 4, 5, 6, 7);
}
DI void lds_barrier() { asm volatile("s_waitcnt lgkmcnt(0)" ::: "memory"); __builtin_amdgcn_s_barrier(); asm volatile("" ::: "memory"); }
namespace pg8 {
constexpr int BM = 256, BK = 64, HALF = 128, HTB = HALF * BK * 2  , STAGE_BYTES = 8 * HTB, NXCD = 8, WGM = 1;

__host__ __device__ __forceinline__ int lds_byte(int r, int c) { const int st = (r >> 4) * 2 + (c >> 5), rr = r & 15, cc = c & 31, ob = rr * 64 + cc * 2; return st * 1024 + (ob ^ (((ob >> 9) & 1) << 5)); }
__host__ __device__ __forceinline__ void stage_rc(int b, int& R, int& C) { const int st = b / 1024, sb = b % 1024, swz = sb ^ (((sb >> 9) & 1) << 5); R = (st >> 1) * 16 + swz / 64; C = (st & 1) * 32 + (swz % 64) / 2; }
__host__ __device__ __forceinline__ int perm32(int rho) { const int n = rho >> 4, i = rho & 15; return 8 * (i >> 2) + 4 * n + (i & 3); }

struct Unit { int pm, pn; };
struct Gemm { const bf16_t* A; const bf16_t* Bt; int M, N, K; };

struct StaticOrder {
    int nM, nN, nwg, G, c;
    __host__ __device__ void init(int M, int N, int G_, int c_) { nM = M / BM; nN = N / BM; nwg = nM * nN; G = G_; c = c_; }
    __host__ __device__ bool next(int i, Unit& u) const {
        const long L = (long)i * G + c; if (L >= nwg) return false;
        int wgid = (int)L; { const int q = nwg / NXCD, r = nwg % NXCD, xcd = wgid % NXCD, off = wgid / NXCD; wgid = (xcd < r ? xcd * (q + 1) : r * (q + 1) + (xcd - r) * q) + off; }
        const int nig = WGM * nN, gid = wgid / nig, fm = gid * WGM, gsz = (nM - fm) < WGM ? (nM - fm) : WGM;
        u.pm = fm + ((wgid % nig) % gsz); u.pn = (wgid % nig) / gsz; return true;
    }
    __device__ __forceinline__ void a_ready(const Unit&) const {}
    __device__ __forceinline__ void done(const Unit&) const {}
};

struct EpiP {
    static constexpr bool PERM = true, AFTER_DRAIN = false;
    bf16_t* P; const float* rope;
    __device__ __forceinline__ void operator()(const f32x4 (&acc)[2][2][4][2], const Unit& u, int wr, int wc, int fr, int fq) const {
        const int row0 = u.pm * BM + wr * 64 + fr, col0 = u.pn * BM + wc * 32 + 8 * fq;
        const int mode = u.pn < 2 ? 1 : (u.pn < 4 ? 2 : 0);
        const float sc = mode == 2 ? 0.08838834764831845f : 1.0f;
        const int mp = 16 * wc + 4 * fq;
#pragma unroll
        for (int ai = 0; ai < 2; ++ai) {
          f32x4 rr0[4], rr1[4];
#pragma unroll
          for (int m = 0; m < 4; ++m) { rr0[m] = (f32x4){1.f, 0.f, 1.f, 0.f}; rr1[m] = rr0[m];
              if (mode) { const float* rp = rope + ((size_t)((row0 + ai * HALF + m * 16) & (SEQ - 1)) * 64 + mp) * 2; rr0[m] = *(const f32x4*)rp; rr1[m] = *(const f32x4*)(rp + 4); } }
          asm volatile("" ::: "memory");
#pragma unroll
            for (int m = 0; m < 4; ++m) {
                const int row = row0 + ai * HALF + m * 16;
                bf16_t* rowp = P + (size_t)row * DIN + col0;
                const f32x4 r0 = rr0[m], r1 = rr1[m];
#pragma unroll
                for (int bj = 0; bj < 2; ++bj) {
                    f32x4 v0 = acc[ai][bj][m][0], v1 = acc[ai][bj][m][1];
                    if (mode) {
                        f32x4 a, b;
                        a[0] = v0[0] * r0[0] - v0[1] * r0[1]; a[1] = v0[0] * r0[1] + v0[1] * r0[0];
                        a[2] = v0[2] * r0[2] - v0[3] * r0[3]; a[3] = v0[2] * r0[3] + v0[3] * r0[2];
                        b[0] = v1[0] * r1[0] - v1[1] * r1[1]; b[1] = v1[0] * r1[1] + v1[1] * r1[0];
                        b[2] = v1[2] * r1[2] - v1[3] * r1[3]; b[3] = v1[2] * r1[3] + v1[3] * r1[2];
                        v0 = a * sc; v1 = b * sc;
                    }
                    u32x4 w; w.x = pk2(v0[0], v0[1]); w.y = pk2(v0[2], v0[3]); w.z = pk2(v1[0], v1[1]); w.w = pk2(v1[2], v1[3]);
                    *(u32x4*)(rowp + bj * HALF) = w;
                }
            }
          asm volatile("" ::: "memory");
        }
    }
};
struct EpiKV {
    static constexpr bool PERM = true, AFTER_DRAIN = false;
    bf16_t* O;
    __device__ __forceinline__ void operator()(const f32x4 (&acc)[2][2][4][2], const Unit& u, int wr, int wc, int fr, int fq) const {
        const int row0 = u.pm * BM + wr * 64 + fr, col0 = u.pn * BM + wc * 32 + 8 * fq;
        const float sc = u.pn < 2 ? 0.08838834764831845f : 1.0f;
#pragma unroll
        for (int ai = 0; ai < 2; ++ai)
#pragma unroll
            for (int m = 0; m < 4; ++m) {
                bf16_t* rowp = O + (size_t)(row0 + ai * HALF + m * 16) * 1024 + col0;
#pragma unroll
                for (int bj = 0; bj < 2; ++bj) {
                    const f32x4 v0 = acc[ai][bj][m][0] * sc, v1 = acc[ai][bj][m][1] * sc;
                    u32x4 w; w.x = pk2(v0[0], v0[1]); w.y = pk2(v0[2], v0[3]); w.z = pk2(v1[0], v1[1]); w.w = pk2(v1[2], v1[3]);
                    *(u32x4*)(rowp + bj * HALF) = w;
                }
            }
    }
};
struct EpiRes {
    static constexpr bool PERM = false, AFTER_DRAIN = false;
    const float* resid; float* out; const float* gate;
    __device__ __forceinline__ void operator()(const f32x4 (&acc)[2][2][4][2], const Unit& u, int wr, int wc, int fr, int fq) const {
        const int row0 = u.pm * BM + wr * 64 + fr, col0 = u.pn * BM + wc * 32 + 4 * fq;
        const int b = (u.pm * BM) >> 12;
        f32x4 gv[2][2];
#pragma unroll
        for (int bj = 0; bj < 2; ++bj)
#pragma unroll
            for (int n = 0; n < 2; ++n) gv[bj][n] = *(const f32x4*)(gate + (size_t)b * 6144 + col0 + bj * HALF + n * 16);
#pragma unroll
        for (int ai = 0; ai < 2; ++ai) {
            f32x4 r[4][2][2];
#pragma unroll
            for (int m = 0; m < 4; ++m)
#pragma unroll
                for (int bj = 0; bj < 2; ++bj)
#pragma unroll
                    for (int n = 0; n < 2; ++n) r[m][bj][n] = *(const f32x4*)(resid + (size_t)(row0 + ai * HALF + m * 16) * DM + col0 + bj * HALF + n * 16);
            asm volatile("" ::: "memory");
#pragma unroll
            for (int m = 0; m < 4; ++m)
#pragma unroll
                for (int bj = 0; bj < 2; ++bj)
#pragma unroll
                    for (int n = 0; n < 2; ++n) *(f32x4*)(out + (size_t)(row0 + ai * HALF + m * 16) * DM + col0 + bj * HALF + n * 16) = r[m][bj][n] + gv[bj][n] * acc[ai][bj][m][n];
            asm volatile("" ::: "memory");
        }
    }
};
struct EpiSwiGLU {
    static constexpr bool PERM = true, AFTER_DRAIN = false;
    bf16_t* O;
    __device__ __forceinline__ void operator()(const f32x4 (&acc)[2][2][4][2], const Unit& u, int wr, int wc, int fr, int fq) const {
        const int row0 = u.pm * BM + wr * 64 + fr, col0 = u.pn * HALF + wc * 32 + 8 * fq;
#pragma unroll
        for (int ai = 0; ai < 2; ++ai)
#pragma unroll
            for (int m = 0; m < 4; ++m) {
                bf16_t* rowp = O + (size_t)(row0 + ai * HALF + m * 16) * DFF + col0;
                const f32x4 g0 = acc[ai][0][m][0], g1 = acc[ai][0][m][1];
                const f32x4 t0 = g0 * -1.4426950408889634f, t1 = g1 * -1.4426950408889634f;
                f32x4 e0, e1;
#pragma unroll
                for (int j = 0; j < 4; ++j) { e0[j] = __builtin_amdgcn_exp2f(t0[j]); e1[j] = __builtin_amdgcn_exp2f(t1[j]); }
                const f32x4 d0 = e0 + 1.0f, d1 = e1 + 1.0f;
                f32x4 r0, r1;
#pragma unroll
                for (int j = 0; j < 4; ++j) { r0[j] = __builtin_amdgcn_rcpf(d0[j]); r1[j] = __builtin_amdgcn_rcpf(d1[j]); }
                const f32x4 v0 = (g0 * acc[ai][1][m][0]) * r0, v1 = (g1 * acc[ai][1][m][1]) * r1;
                u32x4 w; w.x = pk2(v0[0], v0[1]); w.y = pk2(v0[2], v0[3]); w.z = pk2(v1[0], v1[1]); w.w = pk2(v1[2], v1[3]);
                *(u32x4*)rowp = w;
            }
    }
};

struct EpiGateBf {
    static constexpr bool PERM = true, AFTER_DRAIN = false;
    bf16_t* O; const float* gate;
    __device__ __forceinline__ void operator()(const f32x4 (&acc)[2][2][4][2], const Unit& u, int wr, int wc, int fr, int fq) const {
        const int row0 = u.pm * BM + wr * 64 + fr, col0 = u.pn * BM + wc * 32 + 8 * fq;
        const int b = (u.pm * BM) >> 12;
        f32x4 gv[2][2];
#pragma unroll
        for (int bj = 0; bj < 2; ++bj)
#pragma unroll
            for (int n = 0; n < 2; ++n) gv[bj][n] = *(const f32x4*)(gate + (size_t)b * 6144 + col0 + bj * HALF + 4 * n);
#pragma unroll
        for (int ai = 0; ai < 2; ++ai)
#pragma unroll
            for (int m = 0; m < 4; ++m) {
                bf16_t* rowp = O + (size_t)(row0 + ai * HALF + m * 16) * DM + col0;
#pragma unroll
                for (int bj = 0; bj < 2; ++bj) {
                    const f32x4 v0 = acc[ai][bj][m][0] * gv[bj][0], v1 = acc[ai][bj][m][1] * gv[bj][1];
                    u32x4 w; w.x = pk2(v0[0], v0[1]); w.y = pk2(v0[2], v0[3]); w.z = pk2(v1[0], v1[1]); w.w = pk2(v1[2], v1[3]);
                    *(u32x4*)(rowp + bj * HALF) = w;
                }
            }
    }
};
template <class Epi, class Sched>
__device__ __forceinline__ void gemm_phase(PG8_LAS unsigned char* lds, const Gemm g, const Sched& S, const Epi& E) {
    const int tid = threadIdx.x, wid = __builtin_amdgcn_readfirstlane(tid >> 6), lane = tid & 63, wr = wid >> 2, wc = wid & 3, fr = lane & 15, fq = lane >> 4;
    const int K = g.K, nt = K / BK;
    unsigned voffA[2], voffB[2];
#pragma unroll
    for (int i = 0; i < 2; ++i) { int R, C; stage_rc(tid * 16 + i * 8192, R, C); const int Rb = Epi::PERM ? ((R & ~31) + perm32(R & 31)) : R;
        voffA[i] = (unsigned)(R * K + C) * 2u; voffB[i] = (unsigned)(Rb * K + C) * 2u; }
    const size_t kstep = (size_t)(BK * 2);
    const size_t hstep = (size_t)HALF * K * 2;
    const size_t tstep = 2 * hstep;
    const unsigned ldsw = (unsigned)wid * 1024u;
    const int aoff = lds_byte(wr * 64 + fr, fq * 8), boff = lds_byte(wc * 32 + fr, fq * 8);
#define PG8_SA(b, h) (((b) * 2 + (h)) * HTB)
#define PG8_SB(b, h) ((4 + (b) * 2 + (h)) * HTB)
#define PG8_STAGE(bufoff, gbase, voff) do { _Pragma("unroll") for (int _i = 0; _i < 2; ++_i) \
        __builtin_amdgcn_global_load_lds((const unsigned*)((const char*)(gbase) + (voff)[_i]), (PG8_LAS unsigned*)(lds + (bufoff) + ldsw + _i * 8192), 16, 0, 0); } while (0)
#define PG8_LDA(dst, b, h) do { _Pragma("unroll") for (int m = 0; m < 4; ++m) _Pragma("unroll") for (int k = 0; k < 2; ++k) dst[m][k] = *(const PG8_LAS bf16x8*)(lds + PG8_SA(b, h) + aoff + m * 2048 + k * 1024); } while (0)
#define PG8_LDB(dst, b, h) do { _Pragma("unroll") for (int n = 0; n < 2; ++n) _Pragma("unroll") for (int k = 0; k < 2; ++k) dst[n][k] = *(const PG8_LAS bf16x8*)(lds + PG8_SB(b, h) + boff + n * 2048 + k * 1024); } while (0)
#define PG8_MMA(ai, bj, At, Bt) do { __builtin_amdgcn_s_setprio(1); _Pragma("unroll") for (int m = 0; m < 4; ++m) _Pragma("unroll") for (int n = 0; n < 2; ++n) _Pragma("unroll") for (int k = 0; k < 2; ++k) \
        acc[ai][bj][m][n] = __builtin_amdgcn_mfma_f32_16x16x32_bf16(Bt[n][k], At[m][k], acc[ai][bj][m][n], 0, 0, 0); __builtin_amdgcn_s_setprio(0); } while (0)
#define PG8_WAIT_V(n) asm volatile("s_waitcnt vmcnt(" #n ")" ::: "memory")
#define PG8_WAIT_L(n) asm volatile("s_waitcnt lgkmcnt(" #n ")" ::: "memory")
#define PG8_BAR __builtin_amdgcn_s_barrier()
#define PG8_SCHED __builtin_amdgcn_sched_barrier(0)
    Unit cur, nxt; int ui = 0;
    if (!S.next(0, cur)) return;
    f32x4 acc[2][2][4][2];
#pragma unroll
    for (int a = 0; a < 2; ++a)
#pragma unroll
        for (int b = 0; b < 2; ++b)
#pragma unroll
            for (int m = 0; m < 4; ++m)
#pragma unroll
                for (int n = 0; n < 2; ++n) acc[a][b][m][n] = (f32x4){0.f, 0.f, 0.f, 0.f};
    bf16x8 At[4][2], B0[2][2], B1[2][2];
    const char* cA = (const char*)g.A + (size_t)cur.pm * tstep; const char* cB = (const char*)g.Bt + (size_t)cur.pn * tstep;
    S.a_ready(cur);
    PG8_STAGE(PG8_SB(0, 0), cB, voffB); PG8_STAGE(PG8_SA(0, 0), cA, voffA); PG8_STAGE(PG8_SB(0, 1), cB + hstep, voffB); PG8_STAGE(PG8_SA(0, 1), cA + hstep, voffA);
    if (wr == 1) PG8_BAR;
    PG8_WAIT_V(4); PG8_BAR;
    PG8_STAGE(PG8_SB(1, 0), cB + kstep, voffB); PG8_STAGE(PG8_SA(1, 0), cA + kstep, voffA); PG8_STAGE(PG8_SB(1, 1), cB + hstep + kstep, voffB);
    PG8_WAIT_V(6); PG8_BAR;
    for (;;) {
        const bool has_next = S.next(ui + 1, nxt);
        const char* nA = has_next ? (const char*)g.A + (size_t)nxt.pm * tstep : cA; const char* nB = has_next ? (const char*)g.Bt + (size_t)nxt.pn * tstep : cB;
        for (int t = 0; t < nt; t += 2) {
            const bool last = (t == nt - 2);
            const char* a1 = cA + (size_t)(t + 1) * kstep;
            const char* a2 = last ? nA : cA + (size_t)(t + 2) * kstep; const char* b2 = last ? nB : cB + (size_t)(t + 2) * kstep;
            const char* a3 = a2 + kstep; const char* b3 = b2 + kstep;
            if (last && has_next) S.a_ready(nxt);
            PG8_LDB(B0, 0, 0); PG8_SCHED; PG8_LDA(At, 0, 0); PG8_STAGE(PG8_SA(1, 1), a1 + hstep, voffA);
            PG8_WAIT_L(8); PG8_BAR; PG8_WAIT_L(0); PG8_MMA(0, 0, At, B0); PG8_BAR; PG8_SCHED;
            PG8_LDB(B1, 0, 1); PG8_STAGE(PG8_SB(0, 0), b2, voffB);
            PG8_BAR; PG8_WAIT_L(0); PG8_MMA(0, 1, At, B1); PG8_BAR;
            PG8_LDA(At, 0, 1); PG8_STAGE(PG8_SA(0, 0), a2, voffA);
            PG8_BAR; PG8_WAIT_L(0); PG8_MMA(1, 0, At, B0); PG8_BAR; PG8_SCHED;
            PG8_STAGE(PG8_SB(0, 1), b2 + hstep, voffB);
            PG8_WAIT_V(6); PG8_BAR; PG8_MMA(1, 1, At, B1); PG8_BAR;
            PG8_LDB(B0, 1, 0); PG8_SCHED; PG8_LDA(At, 1, 0); PG8_STAGE(PG8_SA(0, 1), a2 + hstep, voffA);
            PG8_WAIT_L(8); PG8_BAR; PG8_WAIT_L(0); PG8_MMA(0, 0, At, B0); PG8_BAR; PG8_SCHED;
            PG8_LDB(B1, 1, 1); PG8_STAGE(PG8_SB(1, 0), b3, voffB);
            PG8_BAR; PG8_WAIT_L(0); PG8_MMA(0, 1, At, B1); PG8_BAR;
            PG8_LDA(At, 1, 1); PG8_STAGE(PG8_SA(1, 0), a3, voffA);
            PG8_BAR; PG8_WAIT_L(0); PG8_MMA(1, 0, At, B0); PG8_BAR; PG8_SCHED;
            PG8_STAGE(PG8_SB(1, 1), b3 + hstep, voffB);
            PG8_WAIT_V(6); PG8_BAR; PG8_MMA(1, 1, At, B1); PG8_BAR;
        }
        if constexpr (!Epi::AFTER_DRAIN) { E(acc, cur, wr, wc, fr, fq); S.done(cur); }
        if (!has_next) break;
#pragma unroll
        for (int a = 0; a < 2; ++a)
#pragma unroll
            for (int b = 0; b < 2; ++b)
#pragma unroll
                for (int m = 0; m < 4; ++m)
#pragma unroll
                    for (int n = 0; n < 2; ++n) acc[a][b][m][n] = (f32x4){0.f, 0.f, 0.f, 0.f};
        cur = nxt; cA = nA; cB = nB; ++ui;
    }
    PG8_WAIT_V(0);
    if (wr == 0) PG8_BAR;
    PG8_BAR;
    if constexpr (Epi::AFTER_DRAIN) { E.fused(acc, cur, wr, wc, fr, fq, lds, wid, lane); S.done(cur); }
#undef PG8_SA
#undef PG8_SB
#undef PG8_STAGE
#undef PG8_LDA
#undef PG8_LDB
#undef PG8_MMA
#undef PG8_WAIT_V
#undef PG8_WAIT_L
#undef PG8_BAR
#undef PG8_SCHED
}
}
#define XB_TMO      128
#define XB_XCNT(j)  (256  + 64 * (j))
#define XB_XSUB(j)  (1280 + 64 * (j))
#define XB_XGEN(j)  (2304 + 64 * (j))
#define XB_TOP      3328
#define XB_TOPGEN   3392
#define XCD_BAR_WORDS 3456
#define XB_SPIN_CAP (1u << 18)

__device__ __forceinline__ unsigned xb_ld(unsigned* p)              { return __hip_atomic_load(p, __ATOMIC_RELAXED, __HIP_MEMORY_SCOPE_AGENT); }
__device__ __forceinline__ unsigned xb_add(unsigned* p, unsigned v) { return __hip_atomic_fetch_add(p, v, __ATOMIC_RELAXED, __HIP_MEMORY_SCOPE_AGENT); }
__device__ __forceinline__ unsigned xb_xcc_id() { return (unsigned)__builtin_amdgcn_s_getreg((3 << 11) | 20) & 0xFu; }
#define XB_SPIN(cond, bar) do { unsigned _sp = 0; while (cond) { __builtin_amdgcn_s_sleep(1); \
    if ((++_sp & 255u) == 0u) { if (xb_ld(&(bar)[XB_TMO])) break; if (_sp > XB_SPIN_CAP) { atomicAdd(&(bar)[XB_TMO], 1u); break; } } } } while (0)

struct XcdBarrier {
    unsigned* bar; unsigned x;
    volatile LAS unsigned* st;
};

__device__ __forceinline__ XcdBarrier xcd_barrier_post(unsigned* bar, volatile LAS unsigned* st) {
    XcdBarrier b; b.bar = bar; b.x = xb_xcc_id(); b.st = st;
    if (threadIdx.x == 0) (void)xb_add(&bar[XB_XCNT(b.x)], 1u);
    return b;
}
__device__ __forceinline__ void xcd_barrier_complete(unsigned* bar, unsigned x, unsigned& nloc, unsigned& nx) {
    const unsigned G = gridDim.x * gridDim.y * gridDim.z;
    unsigned sum, cnt, mine, sp = 0u;
    for (;;) {
        sum = 0u; cnt = 0u; mine = 0u;
#pragma unroll
        for (unsigned j = 0; j < 16; ++j) { const unsigned c = xb_ld(&bar[XB_XCNT(j)]); sum += c; cnt += (c > 0u) ? 1u : 0u; mine = (j == x) ? c : mine; }
        if (sum == G) break;
        __builtin_amdgcn_s_sleep(1);
        if ((++sp & 255u) == 0u) { if (xb_ld(&bar[XB_TMO])) break; if (sp > XB_SPIN_CAP) { atomicAdd(&bar[XB_TMO], 1u); break; } }
    }
    nloc = mine > 0u ? mine : 1u; nx = cnt > 0u ? cnt : 1u;
}

__device__ __forceinline__ void xcd_barrier(const XcdBarrier& b) {
    asm volatile("s_waitcnt vmcnt(0)" ::: "memory");
    __syncthreads();
    if (threadIdx.x == 0) {
        unsigned* bar = b.bar;
        __builtin_amdgcn_s_waitcnt(0);
        unsigned nloc = b.st[0], nx = b.st[1];
        if (nloc == 0u) { xcd_barrier_complete(bar, b.x, nloc, nx); b.st[0] = nloc; b.st[1] = nx; }
        const unsigned old = xb_add(&bar[XB_XSUB(b.x)], 1u);
        const unsigned gen = old / nloc;
        if (old + 1u == (gen + 1u) * nloc) {
            __builtin_amdgcn_fence(__ATOMIC_RELEASE, "agent");
            asm volatile("s_waitcnt vmcnt(0)" ::: "memory");
            const unsigned og = xb_add(&bar[XB_TOP], 1u);
            const unsigned tg = og / nx;
            if (og + 1u == (tg + 1u) * nx) xb_add(&bar[XB_TOPGEN], 1u);
            else XB_SPIN(xb_ld(&bar[XB_TOPGEN]) == tg, bar);
            __builtin_amdgcn_fence(__ATOMIC_ACQUIRE, "agent");
            xb_add(&bar[XB_XGEN(b.x)], 1u);
            asm volatile("s_waitcnt vmcnt(0)" ::: "memory");
        } else {
            XB_SPIN(xb_ld(&bar[XB_XGEN(b.x)]) == gen, bar);
            __builtin_amdgcn_fence(__ATOMIC_ACQUIRE, "agent");
            asm volatile("s_waitcnt vmcnt(0)" ::: "memory");
        }
    }
    __syncthreads();
}

DI int src_col(int kind, int n) {
    if (kind == 0) { if (n < 1024) { const int hh = n >> 7, ch = n & 127; return hh * 128 + (ch >> 1) + 64 * (ch & 1); } return n; }
    if (kind == 2) { const int pn = n >> 8, bj = (n >> 7) & 1, i = n & 127; return bj * DFF + 128 * pn + i; }
    return n;
}
struct TrTile { const float* W; bf16_t* Wt; int K, N, kind, n0, k0; };
DI TrTile tr_decode(const Params& p, int i) {
    TrTile t; int tile;
    if (i < (DIN / 64) * (DM / 64)) { t.W = p.in[8]; t.Wt = (bf16_t*)(p.ws + WS_WIN); t.K = DM; t.N = DIN; t.kind = 0; tile = i; }
    else if ((i -= (DIN / 64) * (DM / 64)) < (DM / 64) * (DM / 64)) { t.W = p.in[23]; t.Wt = (bf16_t*)(p.ws + WS_WOUT); t.K = DM; t.N = DM; t.kind = 1; tile = i; }
    else if ((i -= (DM / 64) * (DM / 64)) < (2 * DFF / 64) * (DM / 64)) { t.W = p.in[24]; t.Wt = (bf16_t*)(p.ws + WS_WGU); t.K = DM; t.N = 2 * DFF; t.kind = 2; tile = i; }
    else { i -= (2 * DFF / 64) * (DM / 64); t.W = p.in[25]; t.Wt = (bf16_t*)(p.ws + WS_WDN); t.K = DFF; t.N = DM; t.kind = 3; tile = i; }
    const int ntk = t.K / 64; t.n0 = (tile / ntk) * 64; t.k0 = (tile % ntk) * 64;
    return t;
}
DI void transpose_tiles(unsigned char* lds, const Params& p, int i0, int stride, int n_tiles) {
    const int tid = threadIdx.x;
    float v[8];
#define TR_LOAD(T) do { _Pragma("unroll") for (int e = 0; e < 8; ++e) { const int idx = tid + NTHR * e, kk = idx >> 6, nn = idx & 63; v[e] = (T).W[(size_t)((T).k0 + kk) * (T).N + src_col((T).kind, (T).n0 + nn)]; } } while (0)
    if (i0 >= n_tiles) return;
    TrTile cur = tr_decode(p, i0);
    TR_LOAD(cur);
    int par = 0;
    for (int i = i0; i < n_tiles; i += stride, par ^= 1) {
        bf16_t* T = (bf16_t*)lds + par * (64 * 72);
#pragma unroll
        for (int e = 0; e < 8; ++e) { const int idx = tid + NTHR * e, kk = idx >> 6, nn = idx & 63; T[nn * 72 + kk] = f2bf(v[e]); }
        const TrTile done = cur;
        if (i + stride < n_tiles) { cur = tr_decode(p, i + stride); TR_LOAD(cur); }
        lds_barrier();
        { const int nn = tid >> 3, seg = tid & 7; *(u32x4*)(done.Wt + (size_t)(done.n0 + nn) * done.K + done.k0 + 8 * seg) = *(const u32x4*)(T + nn * 72 + 8 * seg); }
    }
    lds_barrier();
#undef TR_LOAD
}
DI void mod_item(unsigned char* lds, const Params& p, int item) {
    float* S = (float*)lds;
    float* R = S + 9 * 1024;
    const int tid = threadIdx.x;
    for (int i = tid; i < 9 * 1024; i += NTHR) { const float v = i < 8192 ? p.in[1][i] : p.in[3][i - 8192]; S[i] = v / (1.0f + __expf(-v)); }
    __syncthreads();
    const int nn = tid & 63, ks = tid >> 6, n = item * 64 + nn;
    float acc[9];
#pragma unroll
    for (int r = 0; r < 9; ++r) acc[r] = 0.f;
    const float* wm = p.in[4] + n;
#pragma unroll 4
    for (int kk = 0; kk < 128; kk += 4) {
        const int k = ks * 128 + kk;
        const float w0 = wm[(size_t)k * 6144], w1 = wm[(size_t)(k + 1) * 6144], w2 = wm[(size_t)(k + 2) * 6144], w3 = wm[(size_t)(k + 3) * 6144];
#pragma unroll
        for (int r = 0; r < 9; ++r) { const f32x4 sv = *(const f32x4*)(S + r * 1024 + k); acc[r] += sv[0] * w0 + sv[1] * w1 + sv[2] * w2 + sv[3] * w3; }
    }
#pragma unroll
    for (int r = 0; r < 9; ++r) R[(ks * 9 + r) * 64 + nn] = acc[r];
    __syncthreads();
    for (int i = tid; i < 9 * 64; i += NTHR) {
        const int r = i >> 6, c = i & 63; float s = p.in[5][item * 64 + c];
#pragma unroll
        for (int k2 = 0; k2 < 8; ++k2) s += R[(k2 * 9 + r) * 64 + c];
        ((float*)(p.ws + WS_MOD))[r * 6144 + item * 64 + c] = s;
    }
    __syncthreads();
}
DI void filt_item(unsigned char* lds, const Params& p, int item, bool& staged) {
    float* E = (float*)lds;
    float* H1 = E + 8 * 36;
    float* H2 = H1 + 512;
    float* W1 = (float*)(lds + 65536);
    float* W2 = W1 + 33 * 64;
    float* W3 = W2 + 64 * 64;
    const int tid = threadIdx.x, tt = tid >> 6, j = tid & 63, t = item * 8 + tt;
    if (!staged) { staged = true;
        for (int i = tid; i < 33 * 64; i += NTHR) W1[i] = p.in[13][i];
        for (int i = tid; i < 64 * 64; i += NTHR) { W2[i] = p.in[15][i]; W3[i] = p.in[17][i]; } }
    if (j < 33) {
        float v;
        if (j == 0) v = (float)((double)t / 4095.0);
        else {
            const int bi = (j - 1) & 15;
            const double f = (double)(1e-4f) + (double)bi * (((double)15.0f - (double)1e-4f) / 15.0);
            double xr = f * (double)t * (1.0 / 4096.0); xr -= floor(xr);
            const float ang = 6.283185307179586f * (float)xr;
            v = j <= 16 ? cosf(ang) : -sinf(ang);
        }
        E[tt * 36 + j] = v;
    }
    __syncthreads();
    const float fr = p.in[20][j];
    { float a = p.in[14][j];
#pragma unroll
      for (int i = 0; i < 33; ++i) a += E[tt * 36 + i] * W1[i * 64 + j];
      H1[tt * 64 + j] = sinf(fr * a); }
    __syncthreads();
    { float a = p.in[16][j];
#pragma unroll 16
      for (int i = 0; i < 64; ++i) a += H1[tt * 64 + i] * W2[i * 64 + j];
      H2[tt * 64 + j] = sinf(fr * a); }
    __syncthreads();
    { float a = p.in[18][j];
#pragma unroll 16
      for (int i = 0; i < 64; ++i) a += H2[tt * 64 + i] * W3[i * 64 + j];
      ((float*)(p.ws + WS_FH3))[(size_t)t * 64 + j] = sinf(fr * a); }
    __syncthreads();
}
constexpr int T_WIN = (DIN / 64) * (DM / 64), T_WOUT = (DM / 64) * (DM / 64), T_WGU = (2 * DFF / 64) * (DM / 64), T_WDN = (DM / 64) * (DFF / 64);
DI void phase0(unsigned char* lds, const Params& p) {
    const int tid = threadIdx.x;
    { float* rope = (float*)(p.ws + WS_ROPE);
      for (int idx = blockIdx.x * NTHR + tid; idx < SEQ * 64; idx += gridDim.x * NTHR) {
          const int t = idx >> 6, m = idx & 63, row = t >> 6, col = t & 63;
          const float inv = powf(10000.0f, -(float)(m & 31) / 32.0f);
          const float ang = (float)(m < 32 ? row : col) * inv;
          rope[2 * idx] = cosf(ang); rope[2 * idx + 1] = sinf(ang);
      }
      if (blockIdx.x == 0) { for (int i = tid; i < 512 + 1024; i += NTHR) ((float*)(p.ws + WS_KSUM))[i] = 0.f; } }
    bool fw_staged = false;
    if (gridDim.x >= 192) {
        if (blockIdx.x < 96) mod_item(lds, p, blockIdx.x);
        else { const int blk = blockIdx.x - 96, nblk = gridDim.x - 96;
            for (int it = blk; it < 512; it += nblk) filt_item(lds, p, it, fw_staged);
            transpose_tiles(lds, p, blk, nblk, T_WIN); }
        return;
    }
    for (int it = blockIdx.x; it < 96 + 512; it += gridDim.x) {
        if (it < 96) mod_item(lds, p, it); else filt_item(lds, p, it - 96, fw_staged);
    }
    transpose_tiles(lds, p, blockIdx.x, gridDim.x, T_WIN);
}

struct NormRow { f32x4 v[4]; u32x2 ad[4]; };
DI void nrow_load(NormRow& R, const float* s, const bf16_t* ad, int lane) {
#pragma unroll
    for (int k = 0; k < 4; ++k) { const int c = 4 * lane + 256 * k; R.v[k] = *(const f32x4*)(s + c); if (ad) R.ad[k] = *(const u32x2*)(ad + c); }
}
DI void norm_rows(const float* src, const bf16_t* addend, float* xsum, bf16_t* dst, int row_lo, int row_hi, const float* gain, const float* mod, int shift_i, int scale_i, int ctx_row, int blk, int nblk) {
    const bool has_ad = addend != nullptr;
    const int lane = threadIdx.x & 63, w = threadIdx.x >> 6, nw = nblk * 8, wid = blk * 8 + w;
    const int per = (row_hi - row_lo + nw - 1) / nw;
    const int r0 = row_lo + wid * per, r1 = (r0 + per < row_hi) ? r0 + per : row_hi;
    if (r0 >= r1) return;
    f32x4 A[4], Bm[4]; int curb = -1;
    NormRow R[4];
#define NR_LOAD(set, row) nrow_load(R[set], src + (size_t)((row) - row_lo) * DM, has_ad ? addend + (size_t)((row) - row_lo) * DM : nullptr, lane)
#define NR_STEP(u, row) do { if ((row) < r1) { \
        if ((row) + 3 < r1) NR_LOAD(((u) + 3) & 3, (row) + 3); \
        const int b_ = ctx_row >= 0 ? ctx_row : ((row) >> 12); \
        if (b_ != curb) { curb = b_; const float* mr_ = mod + (size_t)b_ * 6144; \
            _Pragma("unroll") for (int k = 0; k < 4; ++k) { const int c = 4 * lane + 256 * k; const f32x4 g_ = *(const f32x4*)(gain + c), sc_ = *(const f32x4*)(mr_ + scale_i * 1024 + c); A[k] = g_ * (sc_ + 1.0f); Bm[k] = *(const f32x4*)(mr_ + shift_i * 1024 + c); } } \
        NormRow& Q = R[u]; \
        if (has_ad) { _Pragma("unroll") for (int k = 0; k < 4; ++k) { Q.v[k] += (f32x4){bflo(Q.ad[k].x), bfhi(Q.ad[k].x), bflo(Q.ad[k].y), bfhi(Q.ad[k].y)}; if (xsum) *(f32x4*)(xsum + (size_t)((row) - row_lo) * DM + 4 * lane + 256 * k) = Q.v[k]; } } \
        float ss = 0.f; \
        _Pragma("unroll") for (int k = 0; k < 4; ++k) ss += Q.v[k][0] * Q.v[k][0] + Q.v[k][1] * Q.v[k][1] + Q.v[k][2] * Q.v[k][2] + Q.v[k][3] * Q.v[k][3]; \
        ss = wave_sum(ss); \
        const float rstd = rsqrtf(ss * (1.0f / DM) + EPSF); \
        _Pragma("unroll") for (int k = 0; k < 4; ++k) { const f32x4 h = Q.v[k] * rstd * A[k] + Bm[k]; u32x2 o; o.x = pk2(h[0], h[1]); o.y = pk2(h[2], h[3]); *(u32x2*)(dst + (size_t)(row) * DM + 4 * lane + 256 * k) = o; } \
    } } while (0)
    NR_LOAD(0, r0); if (r0 + 1 < r1) NR_LOAD(1, r0 + 1); if (r0 + 2 < r1) NR_LOAD(2, r0 + 2);
#pragma unroll 1
    for (int r = r0; r < r1; r += 4) { NR_STEP(0, r); NR_STEP(1, r + 1); NR_STEP(2, r + 2); NR_STEP(3, r + 3); }
#undef NR_LOAD
#undef NR_STEP
}
DI void filt4_item(unsigned char* lds, const Params& p, int item) {
    float* F = (float*)lds;
    const int tid = threadIdx.x, tt = item >> 1, dir = item & 1, t0 = tt * 32, c = tid;
    for (int i = tid; i < 32 * 64; i += NTHR) F[i] = ((const float*)(p.ws + WS_FH3))[(size_t)t0 * 64 + i];
    __syncthreads();
    float w4[64];
#pragma unroll
    for (int j = 0; j < 64; ++j) w4[j] = p.in[19][(size_t)j * 1024 + dir * 512 + c];
    const float mind = logf(0.01f) / 1.5f, maxd = logf(0.01f) / 0.3f;
    const float ad = fabsf(mind + (float)c * ((maxd - mind) / 511.0f));
    float* dst = (float*)(p.ws + WS_KERN) + ((size_t)dir * 512 + c) * SEQ + t0;
    float asum = 0.f;
#pragma unroll 1
    for (int q = 0; q < 8; ++q) {
        f32x4 o;
#pragma unroll
        for (int r = 0; r < 4; ++r) {
            const int tl = q * 4 + r; float a = 0.f;
#pragma unroll
            for (int j = 0; j < 64; j += 4) { const f32x4 fv = *(const f32x4*)(F + tl * 64 + j); a += fv[0] * w4[j] + fv[1] * w4[j + 1] + fv[2] * w4[j + 2] + fv[3] * w4[j + 3]; }
            const float tlin = (float)(t0 + tl) / 4095.0f;
            a *= __expf(-tlin * ad);
            o[r] = a;
            if (!(dir == 1 && t0 + tl == 0)) asum += fabsf(a);
        }
        *(f32x4*)(dst + q * 4) = o;
    }
    atomicAdd((float*)(p.ws + WS_KSUM) + c, asum);
    __syncthreads();
}
struct OneUnit { int pm, pn;
    __device__ bool next(int i, pg8::Unit& u) const { if (i) return false; u.pm = pm; u.pn = pn; return true; }
    __device__ __forceinline__ void a_ready(const pg8::Unit&) const {}
    __device__ __forceinline__ void done(const pg8::Unit&) const {} };
DI void phase1(unsigned char* lds, const Params& p) {
    const float* mod = (const float*)(p.ws + WS_MOD);
    bf16_t* HA = (bf16_t*)(p.ws + WS_HA);
    const bool split = gridDim.x >= 64;
    if (split && blockIdx.x < 32) {
        const int pm = blockIdx.x >> 2, pn = blockIdx.x & 3;
        {
          const int lane = threadIdx.x & 63, w = threadIdx.x >> 6;
          const float* src = p.in[2] + ((size_t)pm * 256 + w * 32) * DM; bf16_t* dst = HA + ((size_t)MTOK + pm * 256 + w * 32) * DM;
          f32x4 A[4], Bm[4];
#pragma unroll
          for (int k = 0; k < 4; ++k) { const int c = 4 * lane + 256 * k; const f32x4 g = *(const f32x4*)(p.in[6] + c), sc = *(const f32x4*)(mod + 8 * 6144 + 1024 + c); A[k] = g * (sc + 1.0f); Bm[k] = *(const f32x4*)(mod + 8 * 6144 + c); }
          f32x4 v[4][4];
#pragma unroll
          for (int r = 0; r < 4; ++r)
#pragma unroll
              for (int k = 0; k < 4; ++k) v[r][k] = *(const f32x4*)(src + (size_t)r * DM + 4 * lane + 256 * k);
#pragma unroll 1
          for (int r0 = 0; r0 < 32; r0 += 4) {
#pragma unroll
              for (int r = 0; r < 4; ++r) {
                  float ss = 0.f;
#pragma unroll
                  for (int k = 0; k < 4; ++k) ss += v[r][k][0] * v[r][k][0] + v[r][k][1] * v[r][k][1] + v[r][k][2] * v[r][k][2] + v[r][k][3] * v[r][k][3];
                  ss = wave_sum(ss);
                  const float rstd = rsqrtf(ss * (1.0f / DM) + EPSF);
                  u32x2 o[4];
#pragma unroll
                  for (int k = 0; k < 4; ++k) { const f32x4 h = v[r][k] * rstd * A[k] + Bm[k]; o[k].x = pk2(h[0], h[1]); o[k].y = pk2(h[2], h[3]); }
                  if (r0 + 4 + r < 32) {
#pragma unroll
                      for (int k = 0; k < 4; ++k) v[r][k] = *(const f32x4*)(src + (size_t)(r0 + 4 + r) * DM + 4 * lane + 256 * k);
                  }
#pragma unroll
                  for (int k = 0; k < 4; ++k) *(u32x2*)(dst + (size_t)(r0 + r) * DM + 4 * lane + 256 * k) = o[k];
              }
          } }
        asm volatile("s_waitcnt vmcnt(0)" ::: "memory");
        __builtin_amdgcn_fence(__ATOMIC_RELEASE, "workgroup"); __syncthreads(); __builtin_amdgcn_fence(__ATOMIC_ACQUIRE, "agent");
        asm volatile("s_waitcnt vmcnt(0)" ::: "memory");
        pg8::Gemm g{HA + (size_t)MTOK * DM, (const bf16_t*)(p.ws + WS_WIN) + (size_t)512 * DM, MCTX, 1024, DM};
        OneUnit S{pm, pn}; pg8::EpiKV E{(bf16_t*)(p.ws + WS_KVC)};
        pg8::gemm_phase<pg8::EpiKV, OneUnit>((LAS unsigned char*)lds, g, S, E);
        return;
    }
    const int blk = split ? blockIdx.x - 32 : blockIdx.x, nblk = split ? gridDim.x - 32 : gridDim.x;
    for (int it = blk; it < 256; it += nblk) filt4_item(lds, p, it);
    norm_rows(p.in[0], nullptr, nullptr, HA, 0, MTOK, p.in[6], mod, 0, 1, -1, blk, nblk);
    if (!split) norm_rows(p.in[2], nullptr, nullptr, HA, MTOK, MTOK + MCTX, p.in[6], mod, 0, 1, 8, blk, nblk);
}

DI void ret_state_item(unsigned char* lds, const Params& p, int item, int variant) {
    const int tid = threadIdx.x, lane = tid & 63, w = tid >> 6;
    const int b = item >> 3, h = (item >> 1) & 3, dir = item & 1, bh = b * 4 + h;
    const bf16_t* P = (const bf16_t*)(p.ws + WS_P);
    const bf16_t* KVC = (const bf16_t*)(p.ws + WS_KVC);
    bf16_t* ST = (bf16_t*)(p.ws + WS_ST);
    constexpr int RS_ROW = 304, RS_IMG = 128 * RS_ROW, RS_BUF = 2 * RS_IMG;
    const float lg = log1pf(-__expf(p.in[9][dir * 4 + h]));
    const float g128 = __expf(lg * 128.0f);
    const int segk = tid & 15, jk0 = tid >> 4;
    float wv[4];
#pragma unroll
    for (int i = 0; i < 4; ++i) { const int j = jk0 + 32 * i; wv[i] = dir == 0 ? __expf(lg * (float)(127 - j)) : __expf(lg * (float)j); }
    u32x4 kreg[2][4], vreg[2][4];
    f32x4 acc[8];
#pragma unroll
    for (int et = 0; et < 8; ++et) acc[et] = (f32x4){0.f, 0.f, 0.f, 0.f};
    const int G = lane >> 4, i16 = lane & 15, q = i16 >> 2, pp = i16 & 3, wd = w >> 2, we = w & 3;
#define RS_LOAD(s, R) do { \
        const bf16_t* kb; size_t ld; \
        if ((s) < 2) { const int cc = dir == 0 ? (s) : 1 - (s); kb = KVC + (size_t)(b * CTXL + cc * 128) * 1024 + h * 128; ld = 1024; } \
        else { const int n = dir == 0 ? (s) - 2 : 31 - ((s) - 2); kb = P + (size_t)(b * SEQ + n * 128) * DIN + 512 + h * 128; ld = DIN; } \
        _Pragma("unroll") for (int i = 0; i < 4; ++i) { kreg[R][i] = *(const u32x4*)(kb + (size_t)(jk0 + 32 * i) * ld + 8 * segk); vreg[R][i] = *(const u32x4*)(kb + 512 + (size_t)(jk0 + 32 * i) * ld + 8 * segk); } } while (0)
#define RS_STEP(s, R, STORE) do { \
        { \
            unsigned char* KI = lds + (R) * RS_BUF; unsigned char* VI = KI + RS_IMG; \
            _Pragma("unroll") for (int i = 0; i < 4; ++i) { \
                *(u32x4*)(KI + (jk0 + 32 * i) * RS_ROW + segk * 16) = kreg[R][i]; \
                const u32x4 vr = vreg[R][i]; const float ww = wv[i]; u32x4 o; o.x = pk2(bflo(vr.x) * ww, bfhi(vr.x) * ww); o.y = pk2(bflo(vr.y) * ww, bfhi(vr.y) * ww); o.z = pk2(bflo(vr.z) * ww, bfhi(vr.z) * ww); o.w = pk2(bflo(vr.w) * ww, bfhi(vr.w) * ww); \
                *(u32x4*)(VI + (jk0 + 32 * i) * RS_ROW + segk * 16) = o; } \
            lds_barrier(); \
            { const int s2_ = (s) + 2 < 33 ? (s) + 2 : 32; RS_LOAD(s2_, R); }        \
            _Pragma("unroll") for (int et = 0; et < 8; ++et) acc[et] *= g128; \
            const LAS unsigned char* kbase = (const LAS unsigned char*)KI; const LAS unsigned char* vbase = (const LAS unsigned char*)VI; \
            _Pragma("unroll") for (int ks = 0; ks < 4; ++ks) {        \
                const int j0 = 32 * ks + 8 * G + q; \
                bf16x8 ak[4], bv[2]; \
                _Pragma("unroll") for (int dt = 0; dt < 4; ++dt) ak[dt] = tr_read8(kbase + j0 * RS_ROW + (64 * wd + 16 * dt + 4 * pp) * 2, 4 * RS_ROW); \
                _Pragma("unroll") for (int et = 0; et < 2; ++et) bv[et] = tr_read8(vbase + j0 * RS_ROW + (32 * we + 16 * et + 4 * pp) * 2, 4 * RS_ROW); \
                _Pragma("unroll") for (int dt = 0; dt < 4; ++dt) \
                _Pragma("unroll") for (int et = 0; et < 2; ++et) acc[dt * 2 + et] = MFMA16(ak[dt], bv[et], acc[dt * 2 + et]); } \
            if (STORE) {        \
                const int n = dir == 0 ? (s) - 1 : 31 - ((s) - 1); \
                  \
                bf16_t* dst = ST + (((size_t)dir * 32 + bh) * 32 + n) * 16384 + (i16 + 16 * (G >> 1)) * 8 + 4 * (G & 1); \
                _Pragma("unroll") for (int dt = 0; dt < 4; ++dt) \
                _Pragma("unroll") for (int et = 0; et < 2; ++et) { const f32x4 a_ = acc[dt * 2 + et]; u32x2 o; o.x = pk2(a_[0], a_[1]); o.y = pk2(a_[2], a_[3]); \
                    *(u32x2*)(dst + (((2 * we + et) * 4 + 2 * wd + (dt >> 1)) * 64 + 32 * (dt & 1)) * 8) = o; } \
            } \
            __builtin_amdgcn_sched_barrier(0);        \
        } } while (0)
    RS_LOAD(0, 0);
    RS_LOAD(1, 1);
    RS_STEP(0, 0, false);
#pragma unroll 1
    for (int s = 1; s < 33; s += 2) { RS_STEP(s, 1, true); RS_STEP(s + 1, 0, true); }
    lds_barrier();
#undef RS_LOAD
#undef RS_STEP
}

DI void unpack8(const u32x4 v, float (&f)[8]) { f[0] = bflo(v.x); f[1] = bfhi(v.x); f[2] = bflo(v.y); f[3] = bfhi(v.y); f[4] = bflo(v.z); f[5] = bfhi(v.z); f[6] = bflo(v.w); f[7] = bfhi(v.w); }
DI void load8f(const float* p, float (&f)[8]) { const f32x4 a = *(const f32x4*)p, b = *(const f32x4*)(p + 4); f[0] = a[0]; f[1] = a[1]; f[2] = a[2]; f[3] = a[3]; f[4] = b[0]; f[5] = b[1]; f[6] = b[2]; f[7] = b[3]; }
DI void hy_u_items(unsigned char* lds, const Params& p, int it0, int stride, int n_items) {
    bf16_t* T = (bf16_t*)lds;
    const int tid = threadIdx.x, row = tid >> 3, seg = tid & 7;
    const bf16_t* Pg = (const bf16_t*)(p.ws + WS_P) + 2048 + 8 * seg;
    const u32x4 z4 = {0u, 0u, 0u, 0u};
    u32x4 xm, x0, xp, vm, v0, vp;
#define HU_LOAD(it) do { const int b_ = (it) >> 9, t_ = (((it) >> 3) & 63) * 64 + row, c0_ = ((it) & 7) * 64; const bf16_t* P_ = Pg + (size_t)b_ * SEQ * DIN + c0_; \
        xm = t_ > 0 ? *(const u32x4*)(P_ + (size_t)(t_ - 1) * DIN + 512) : z4; x0 = *(const u32x4*)(P_ + (size_t)t_ * DIN + 512); xp = t_ < SEQ - 1 ? *(const u32x4*)(P_ + (size_t)(t_ + 1) * DIN + 512) : z4; \
        vm = t_ > 0 ? *(const u32x4*)(P_ + (size_t)(t_ - 1) * DIN + 1024) : z4; v0 = *(const u32x4*)(P_ + (size_t)t_ * DIN + 1024); vp = t_ < SEQ - 1 ? *(const u32x4*)(P_ + (size_t)(t_ + 1) * DIN + 1024) : z4; } while (0)
    if (it0 < n_items) HU_LOAD(it0);
    int par = 0, wct = -1;
    float xw0[8], xw1[8], xw2[8], xbs[8], vw0[8], vw1[8], vw2[8], vbs[8];
    for (int item = it0; item < n_items; item += stride, par ^= 1) {
        const int b = item >> 9, tt = (item >> 3) & 63, ct = item & 7, t0 = tt * 64, c0 = ct * 64;
        if (ct != wct) { wct = ct; const float* sw = p.in[11] + c0 + 8 * seg; const float* sb = p.in[12] + c0 + 8 * seg;
            load8f(sw + 512, xw0); load8f(sw + 1536 + 512, xw1); load8f(sw + 3072 + 512, xw2); load8f(sb + 512, xbs);
            load8f(sw + 1024, vw0); load8f(sw + 1536 + 1024, vw1); load8f(sw + 3072 + 1024, vw2); load8f(sb + 1024, vbs); }
        float u[8];
        { float a[8], bb[8], c[8];
          unpack8(xm, a); unpack8(x0, bb); unpack8(xp, c);
#pragma unroll
          for (int k = 0; k < 8; ++k) u[k] = xbs[k] + xw0[k] * a[k] + xw1[k] * bb[k] + xw2[k] * c[k];
          unpack8(vm, a); unpack8(v0, bb); unpack8(vp, c);
#pragma unroll
          for (int k = 0; k < 8; ++k) u[k] *= vbs[k] + vw0[k] * a[k] + vw1[k] * bb[k] + vw2[k] * c[k]; }
        if (item + stride < n_items) HU_LOAD(item + stride);
        bf16_t* Tb = T + par * (64 * 72);
#pragma unroll
        for (int k = 0; k < 8; k += 2) { const unsigned pk = pk2(u[k], u[k + 1]); Tb[(8 * seg + k) * 72 + (row ^ (8 * seg))] = (bf16_t)(pk & 0xffffu); Tb[(8 * seg + k + 1) * 72 + (row ^ (8 * seg))] = (bf16_t)(pk >> 16); }
        lds_barrier();
        { const int cc = tid >> 3, sg = tid & 7;
          *(u32x4*)((bf16_t*)(p.ws + WS_U) + ((size_t)(c0 + cc) * NB + b) * SEQ + t0 + 8 * sg) = *(const u32x4*)(Tb + cc * 72 + 8 * (sg ^ ((cc >> 3) & 7))); }
    }
    lds_barrier();
#undef HU_LOAD
}

DI void ret_out_items(unsigned char* lds, const Params& p, int it0, int stride, int n_items) {
    const int tid = threadIdx.x, lane = tid & 63, w = tid >> 6;
    const bf16_t* P = (const bf16_t*)(p.ws + WS_P);
    const bf16_t* ST = (const bf16_t*)(p.ws + WS_ST);
    bf16_t* MIX = (bf16_t*)(p.ws + WS_MIXIN);
    constexpr int RO_ROW = 304, RO_IMG = 128 * RO_ROW;
    unsigned char* KB = lds;
    unsigned char* VB = lds + RO_IMG;
    unsigned char* SF = lds + 2 * RO_IMG;
    unsigned char* PI = lds + 2 * RO_IMG + 32768 + w * 5120;
    const int G = lane >> 4, i16 = lane & 15, q = i16 >> 2, pp = i16 & 3;
    const int segk = tid & 15, jk0 = tid >> 4;
    u32x4 kreg[4], vreg[4], sreg[4]; bf16x8 qf[4];
#define RO_LOAD(it) do { const int b_ = (it) >> 7, h_ = ((it) >> 5) & 3, n_ = (it) & 31; const size_t tok_ = (size_t)b_ * SEQ + n_ * 128; \
        const bf16_t* kb_ = P + tok_ * DIN + 512 + h_ * 128; const bf16_t* sf_ = ST + (((size_t)0 * 32 + b_ * 4 + h_) * 32 + n_) * 16384; \
        _Pragma("unroll") for (int i = 0; i < 4; ++i) { const int j_ = jk0 + 32 * i; kreg[i] = *(const u32x4*)(kb_ + (size_t)j_ * DIN + 8 * segk); vreg[i] = *(const u32x4*)(kb_ + 512 + (size_t)j_ * DIN + 8 * segk); \
            sreg[i] = *(const u32x4*)(sf_ + (size_t)(tid + NTHR * i) * 8); } \
        const bf16_t* qb_ = P + (tok_ + 16 * w + i16) * DIN + h_ * 128 + 8 * G; \
        _Pragma("unroll") for (int ks = 0; ks < 4; ++ks) qf[ks] = *(const bf16x8*)(qb_ + 32 * ks); } while (0)
    if (it0 < n_items) RO_LOAD(it0);
  for (int item = it0; item < n_items; item += stride) {
    const int b = item >> 7, h = (item >> 5) & 3, n = item & 31, bh = b * 4 + h;
    const float lgf = log1pf(-__expf(p.in[9][h])), lgb = log1pf(-__expf(p.in[9][4 + h]));
    const float lf2 = lgf * 1.4426950408889634f, lb2 = lgb * 1.4426950408889634f;
    const size_t tok0 = (size_t)b * SEQ + n * 128;
#pragma unroll
    for (int i = 0; i < 4; ++i) {
        const int j = jk0 + 32 * i;
        *(u32x4*)(KB + j * RO_ROW + segk * 16) = kreg[i];
        *(u32x4*)(VB + j * RO_ROW + segk * 16) = vreg[i];
        *(u32x4*)(SF + (tid + NTHR * i) * 16) = sreg[i];
    }
    u32x4 greg[4]; float gnr[8];
    { const bf16_t* gb = P + tok0 * DIN + 1536 + h * 128 + 8 * segk;
#pragma unroll
      for (int i = 0; i < 4; ++i) greg[i] = *(const u32x4*)(gb + (size_t)(jk0 + 32 * i) * DIN);
#pragma unroll
      for (int et = 0; et < 8; ++et) gnr[et] = p.in[10][h * 128 + 16 * et + i16]; }
    lds_barrier();
    int ibase = 16 * w + 4 * G;
    asm volatile("" : "+v"(ibase));
    {
        f32x4 accS[8];
#pragma unroll
        for (int jt = 0; jt < 8; ++jt) {
            accS[jt] = (f32x4){0.f, 0.f, 0.f, 0.f};
#pragma unroll
            for (int ks = 0; ks < 4; ++ks) { const bf16x8 bk = *(const bf16x8*)(KB + (16 * jt + i16) * RO_ROW + (32 * ks + 8 * G) * 2); accS[jt] = MFMA16(qf[ks], bk, accS[jt]); }
            if (jt & 1) __builtin_amdgcn_sched_barrier(0);
        }
#pragma unroll
        for (int jt = 0; jt < 8; ++jt) {
            const int j = 16 * jt + i16; float pv[4];
#pragma unroll
            for (int r = 0; r < 4; ++r) {
                const int diff = ibase + r - j;
                const float ex = __builtin_amdgcn_exp2f((diff > 0 ? lf2 : -lb2) * (float)diff);
                pv[r] = accS[jt][r] * (diff == 0 ? 2.0f : ex);
            }
            u32x2 o; o.x = pk2(pv[0], pv[1]); o.y = pk2(pv[2], pv[3]);
            *(u32x2*)(PI + j * 40 + 8 * G) = o;
        }
    }
    lds_barrier();
    { const bf16_t* sbp = ST + (((size_t)1 * 32 + bh) * 32 + n) * 16384;
#pragma unroll
      for (int i = 0; i < 4; ++i) *(u32x4*)(KB + (tid + NTHR * i) * 16) = *(const u32x4*)(sbp + (size_t)(tid + NTHR * i) * 8); }
    f32x4 accI[8];
    const LAS unsigned char* pbase = (const LAS unsigned char*)PI; const LAS unsigned char* vbase = (const LAS unsigned char*)VB;
#pragma unroll
    for (int et = 0; et < 8; ++et) accI[et] = (f32x4){0.f, 0.f, 0.f, 0.f};
#pragma unroll
    for (int ks = 0; ks < 4; ++ks) {
        const int j0 = 32 * ks + 8 * G + q;
        const bf16x8 ap = tr_read8(pbase + j0 * 40 + 8 * pp, 4 * 40);
#pragma unroll
        for (int et = 0; et < 8; ++et) {
            const bf16x8 bv = tr_read8(vbase + j0 * RO_ROW + (16 * et + 4 * pp) * 2, 4 * RO_ROW);
            accI[et] = MFMA16(ap, bv, accI[et]);
        }
        __builtin_amdgcn_sched_barrier(0);
    }
    float cf[4], cb[4];
#pragma unroll
    for (int r = 0; r < 4; ++r) { const int i = ibase + r; cf[r] = __builtin_amdgcn_exp2f(lf2 * (float)(i + 1)); cb[r] = __builtin_amdgcn_exp2f(lb2 * (float)(128 - i)); }
#pragma unroll
    for (int et = 0; et < 8; ++et) {
        f32x4 accX = (f32x4){0.f, 0.f, 0.f, 0.f};
#pragma unroll
        for (int ks = 0; ks < 4; ++ks) { const bf16x8 bs = *(const bf16x8*)(SF + ((et * 4 + ks) * 64 + lane) * 16); accX = MFMA16(qf[ks], bs, accX); }
#pragma unroll
        for (int r = 0; r < 4; ++r) accI[et][r] += cf[r] * accX[r];
        if (et & 1) __builtin_amdgcn_sched_barrier(0);
    }
    lds_barrier();
    unsigned char* GT = lds + 2 * RO_IMG + 32768;
#pragma unroll
    for (int i = 0; i < 4; ++i) *(u32x4*)(GT + (jk0 + 32 * i) * 272 + segk * 16) = greg[i];
#pragma unroll
    for (int et = 0; et < 8; ++et) {
        f32x4 accX = (f32x4){0.f, 0.f, 0.f, 0.f};
#pragma unroll
        for (int ks = 0; ks < 4; ++ks) { const bf16x8 bs = *(const bf16x8*)(KB + ((et * 4 + ks) * 64 + lane) * 16); accX = MFMA16(qf[ks], bs, accX); }
#pragma unroll
        for (int r = 0; r < 4; ++r) accI[et][r] += cb[r] * accX[r];
        if (et & 1) __builtin_amdgcn_sched_barrier(0);
    }
    if (item + stride < n_items) RO_LOAD(item + stride);
    lds_barrier();
#pragma unroll
    for (int r = 0; r < 4; ++r) {
        float s = 0.f;
#pragma unroll
        for (int et = 0; et < 8; ++et) s += accI[et][r];
        s += __shfl_xor(s, 1); s += __shfl_xor(s, 2); s += __shfl_xor(s, 4); s += __shfl_xor(s, 8);
        const float mu = s * (1.0f / 128.0f);
        float v = 0.f;
#pragma unroll
        for (int et = 0; et < 8; ++et) { const float d = accI[et][r] - mu; v += d * d; }
        v += __shfl_xor(v, 1); v += __shfl_xor(v, 2); v += __shfl_xor(v, 4); v += __shfl_xor(v, 8);
        const float rstd = rsqrtf(v * (1.0f / 128.0f) + EPSF);
        bf16_t* grow = (bf16_t*)(GT + (16 * w + 4 * G + r) * 272) + i16;
#pragma unroll
        for (int et = 0; et < 8; ++et) {
            const float g = bf2f(grow[16 * et]);
            grow[16 * et] = f2bf((accI[et][r] - mu) * rstd * gnr[et] * (g * __builtin_amdgcn_rcpf(1.0f + __builtin_amdgcn_exp2f(-1.4426950408889634f * g))));
        }
    }
    lds_barrier();
#pragma unroll
    for (int i = 0; i < 4; ++i) { const int j = jk0 + 32 * i; *(u32x4*)(MIX + (tok0 + j) * DM + h * 128 + 8 * segk) = *(const u32x4*)(GT + j * 272 + segk * 16); }
    lds_barrier();
  }
#undef RO_LOAD
}

constexpr int KR_OFF = 4112, KR_N = 8208, KR_BYTES = 16640, USH_ROW = 1040, USH_BYTES = 64 * USH_ROW;
DI void conv_item(unsigned char* lds, const Params& p, int c) {
    const int tid = threadIdx.x, lane = tid & 63, w = tid >> 6;
    bf16_t* KR = (bf16_t*)lds;
    unsigned char* USH = lds + KR_BYTES;
    const bf16_t* Ug = (const bf16_t*)(p.ws + WS_U) + (size_t)c * NB * SEQ;
    bf16_t* Yg = (bf16_t*)(p.ws + WS_YC) + (size_t)c * NB * SEQ;
    { const float* kf = (const float*)(p.ws + WS_KERN) + (size_t)c * SEQ; const float* kb = kf + (size_t)512 * SEQ;
      const float sc = 1.0f / (((const float*)(p.ws + WS_KSUM))[c] + EPSF);
      float kv[17];
#pragma unroll
      for (int k = 0; k < 17; ++k) {
          const int y = tid + NTHR * k, m = KR_OFF - y, am = m < 0 ? -m : m, ai = am < SEQ ? am : SEQ - 1;
          kv[k] = (m >= 0 ? kf : kb)[ai];
          if (am >= SEQ) kv[k] = 0.f;
      }
#pragma unroll
      for (int k = 0; k < 17; ++k) { const int y = tid + NTHR * k; if (y < KR_N + 8) KR[y] = f2bf(kv[k] * sc); } }
    const int rh = tid >> 8, sb = (tid >> 5) & 7, sg = tid & 31;
    u32x4 lo[2], hi[2];
#define CV_LOAD(qc) do { _Pragma("unroll") for (int h2 = 0; h2 < 2; ++h2) { const int e0 = -16 + 512 * (qc) + 256 * h2 + 8 * sg, e1 = e0 + 8; \
        lo[h2] = (e0 >= 0 && e0 < SEQ) ? *(const u32x4*)(Ug + (size_t)sb * SEQ + e0) : (u32x4){0u, 0u, 0u, 0u}; \
        hi[h2] = (e1 >= 0 && e1 < SEQ) ? *(const u32x4*)(Ug + (size_t)sb * SEQ + e1) : (u32x4){0u, 0u, 0u, 0u}; } } while (0)
#define CV_WIN(r, dst, h2) do { const unsigned wv[8] = {lo[h2].x, lo[h2].y, lo[h2].z, lo[h2].w, hi[h2].x, hi[h2].y, hi[h2].z, hi[h2].w}; constexpr int e_ = (r) >> 1; u32x4 o_; \
        if ((r) & 1) { o_.x = (wv[e_] >> 16) | (wv[e_ + 1] << 16); o_.y = (wv[e_ + 1] >> 16) | (wv[e_ + 2] << 16); o_.z = (wv[e_ + 2] >> 16) | (wv[e_ + 3] << 16); o_.w = (wv[e_ + 3] >> 16) | (wv[e_ + 4] << 16); } \
        else { o_.x = wv[e_]; o_.y = wv[e_ + 1]; o_.z = wv[e_ + 2]; o_.w = wv[e_ + 3]; } \
        *(u32x4*)((dst) + (sb * 8 + (r)) * USH_ROW + (h2) * 512 + sg * 16) = o_; } while (0)
#define CV_STORE(buf) do { unsigned char* d_ = USH + (buf) * USH_BYTES; \
        if (rh == 0) { CV_WIN(0, d_, 0); CV_WIN(1, d_, 0); CV_WIN(2, d_, 0); CV_WIN(3, d_, 0); CV_WIN(0, d_, 1); CV_WIN(1, d_, 1); CV_WIN(2, d_, 1); CV_WIN(3, d_, 1); } \
        else { CV_WIN(4, d_, 0); CV_WIN(5, d_, 0); CV_WIN(6, d_, 0); CV_WIN(7, d_, 0); CV_WIN(4, d_, 1); CV_WIN(5, d_, 1); CV_WIN(6, d_, 1); CV_WIN(7, d_, 1); } } while (0)
    f32x16 acc[2][2];
#pragma unroll
    for (int a = 0; a < 2; ++a)
#pragma unroll
        for (int b2 = 0; b2 < 2; ++b2)
#pragma unroll
            for (int k = 0; k < 16; ++k) acc[a][b2][k] = 0.f;
    const int i32 = lane & 31, hh = lane >> 5;
    const int ya0 = KR_OFF - 256 * (2 * w) - 8 * i32 - 16 + 8 * hh, ya1 = ya0 - 256;
    const int brow0 = i32 * USH_ROW + hh * 16, brow1 = brow0 + 32 * USH_ROW;
    CV_LOAD(0);
    CV_STORE(0);
    CV_LOAD(1);
    lds_barrier();
#define CV_FRAGS(st_, A0, A1, B0, B1) do { const int sg16_ = (qc * 32 + hf * 16 + (st_)) * 16; \
        A0 = *(const bf16x8*)(KR + ya0 + sg16_); A1 = *(const bf16x8*)(KR + ya1 + sg16_); \
        B0 = *(const bf16x8*)(ub + brow0 + (hf * 16 + (st_)) * 32); B1 = *(const bf16x8*)(ub + brow1 + (hf * 16 + (st_)) * 32); } while (0)
#define CV_MMA(A0, A1, B0, B1) do { acc[0][0] = MFMA32(A0, B0, acc[0][0]); acc[0][1] = MFMA32(A0, B1, acc[0][1]); acc[1][0] = MFMA32(A1, B0, acc[1][0]); acc[1][1] = MFMA32(A1, B1, acc[1][1]); } while (0)
#pragma unroll 1
    for (int qc = 0; qc < 9; ++qc) {
        if (qc + 1 < 9) CV_STORE((qc + 1) & 1);
        if (qc + 2 < 9) CV_LOAD(qc + 2);
        const unsigned char* ub = USH + (qc & 1) * USH_BYTES;
        bf16x8 fa0, fa1, fb0, fb1, ga0, ga1, gb0, gb1;
        if (qc < 8) {
#pragma unroll 1
            for (int hf = 0; hf < 2; ++hf) {
                CV_FRAGS(0, fa0, fa1, fb0, fb1);
#pragma unroll
                for (int st = 0; st < 16; st += 2) {
                    CV_FRAGS(st + 1, ga0, ga1, gb0, gb1);
                    CV_MMA(fa0, fa1, fb0, fb1);
                    if (st + 2 < 16) CV_FRAGS(st + 2, fa0, fa1, fb0, fb1);
                    CV_MMA(ga0, ga1, gb0, gb1);
                }
            }
        } else { const int hf = 0; CV_FRAGS(0, fa0, fa1, fb0, fb1); CV_MMA(fa0, fa1, fb0, fb1); }
        lds_barrier();
    }
#undef CV_FRAGS
#undef CV_MMA
#pragma unroll
    for (int mi = 0; mi < 2; ++mi)
#pragma unroll
        for (int nt = 0; nt < 2; ++nt)
#pragma unroll
            for (int reg = 0; reg < 16; reg += 2) {
                const int i = (reg & 3) + 8 * (reg >> 2) + 4 * hh, bb = 4 * nt + (i32 >> 3), r = i32 & 7;
                const unsigned pk = pk2(acc[mi][nt][reg], acc[mi][nt][reg + 1]);
                bf16_t* yp = Yg + (size_t)bb * SEQ + 256 * (2 * w + mi) + 8 * i + r;
                yp[0] = (bf16_t)(pk & 0xffffu); yp[8] = (bf16_t)(pk >> 16);
            }
    lds_barrier();
#undef CV_LOAD
#undef CV_WIN
#undef CV_STORE
}

DI void hy_fin_item(unsigned char* lds, const Params& p, int item) {
    float* Z = (float*)lds;
    const int tid = threadIdx.x, lane = tid & 63, w = tid >> 6;
    const int b = item >> 6, t0 = (item & 63) * 64;
    { const int c = tid; const float bias = p.in[21][c];
      const bf16_t* yc = (const bf16_t*)(p.ws + WS_YC) + ((size_t)c * NB + b) * SEQ + t0;
      const bf16_t* uu = (const bf16_t*)(p.ws + WS_U) + ((size_t)c * NB + b) * SEQ + t0;
#pragma unroll 8
      for (int seg = 0; seg < 8; ++seg) {
          const u32x4 yv = *(const u32x4*)(yc + 8 * seg), uv = *(const u32x4*)(uu + 8 * seg);
          const unsigned ya[4] = {yv.x, yv.y, yv.z, yv.w}, ua[4] = {uv.x, uv.y, uv.z, uv.w};
#pragma unroll
          for (int k = 0; k < 4; ++k) {
              Z[(8 * seg + 2 * k) * 516 + c] = bflo(ya[k]) + bflo(ua[k]) * bias;
              Z[(8 * seg + 2 * k + 1) * 516 + c] = bfhi(ya[k]) + bfhi(ua[k]) * bias;
          }
      } }
    lds_barrier();
    const bf16_t* P = (const bf16_t*)(p.ws + WS_P) + (size_t)b * SEQ * DIN + 2048 + 8 * lane;
    bf16_t* MIX = (bf16_t*)(p.ws + WS_MIXIN) + (size_t)b * SEQ * DM + 512 + 8 * lane;
    float w0[8], w1[8], w2[8], bs[8], og[8];
    load8f(p.in[11] + 8 * lane, w0); load8f(p.in[11] + 1536 + 8 * lane, w1); load8f(p.in[11] + 3072 + 8 * lane, w2); load8f(p.in[12] + 8 * lane, bs); load8f(p.in[22] + 8 * lane, og);
    const int ts = t0 + 8 * w;
    u32x4 rows[10];
#pragma unroll
    for (int r = 0; r < 10; ++r) { const int t = ts - 1 + r; rows[r] = (t >= 0 && t < SEQ) ? *(const u32x4*)(P + (size_t)t * DIN) : (u32x4){0u, 0u, 0u, 0u}; }
#pragma unroll
    for (int tt = 0; tt < 8; ++tt) {
        const int tl = 8 * w + tt;
        float am[8], a0[8], ap[8], z[8], y[8];
        unpack8(rows[tt], am); unpack8(rows[tt + 1], a0); unpack8(rows[tt + 2], ap);
        load8f(Z + tl * 516 + 8 * lane, z);
        float ss = 0.f;
#pragma unroll
        for (int k = 0; k < 8; ++k) { y[k] = (bs[k] + w0[k] * am[k] + w1[k] * a0[k] + w2[k] * ap[k]) * z[k]; ss += y[k] * y[k]; }
        ss = wave_sum(ss);
        const float rstd = rsqrtf(ss * (1.0f / 512.0f) + EPSF);
        u32x4 o; o.x = pk2(y[0] * rstd * og[0], y[1] * rstd * og[1]); o.y = pk2(y[2] * rstd * og[2], y[3] * rstd * og[3]); o.z = pk2(y[4] * rstd * og[4], y[5] * rstd * og[5]); o.w = pk2(y[6] * rstd * og[6], y[7] * rstd * og[7]);
        *(u32x4*)(MIX + (size_t)(ts + tt) * DM) = o;
    }
    lds_barrier();
}

struct FinRow { f32x4 v[4]; u32x2 a[4], b[4]; };
DI void frow_load(FinRow& R, const float* x, const bf16_t* a, const bf16_t* b, int lane) {
#pragma unroll
    for (int k = 0; k < 4; ++k) { const int c = 4 * lane + 256 * k; R.v[k] = __builtin_nontemporal_load((const f32x4*)(x + c)); R.a[k] = __builtin_nontemporal_load((const u32x2*)(a + c)); R.b[k] = __builtin_nontemporal_load((const u32x2*)(b + c)); }
}
DI void final_norm_rows(const float* x, const bf16_t* mg, const bf16_t* fg, float* out, const float* gain) {
    const int xb = (gridDim.x & 7) ? (int)blockIdx.x : (int)((blockIdx.x & 7) * (gridDim.x >> 3) + (blockIdx.x >> 3));
    const int lane = threadIdx.x & 63, w = threadIdx.x >> 6, nw = gridDim.x * 8, wid = xb * 8 + w;
    const int per = (MTOK + nw - 1) / nw, r0 = wid * per, r1 = (r0 + per < MTOK) ? r0 + per : MTOK;
    if (r0 >= r1) return;
    f32x4 g[4];
#pragma unroll
    for (int k = 0; k < 4; ++k) g[k] = *(const f32x4*)(gain + 4 * lane + 256 * k);
    FinRow R[4];
#define FN_LOAD(set, row) frow_load(R[set], x + (size_t)(row) * DM, mg + (size_t)(row) * DM, fg + (size_t)(row) * DM, lane)
#define FN_STEP(u, row) do { if ((row) < r1) { \
        if ((row) + 3 < r1) FN_LOAD(((u) + 3) & 3, (row) + 3); \
        FinRow& Q = R[u]; float ss = 0.f; \
        _Pragma("unroll") for (int k = 0; k < 4; ++k) { Q.v[k] += (f32x4){bflo(Q.a[k].x), bfhi(Q.a[k].x), bflo(Q.a[k].y), bfhi(Q.a[k].y)}; Q.v[k] += (f32x4){bflo(Q.b[k].x), bfhi(Q.b[k].x), bflo(Q.b[k].y), bfhi(Q.b[k].y)}; \
            ss += Q.v[k][0] * Q.v[k][0] + Q.v[k][1] * Q.v[k][1] + Q.v[k][2] * Q.v[k][2] + Q.v[k][3] * Q.v[k][3]; } \
        ss = wave_sum(ss); \
        const float rstd = rsqrtf(ss * (1.0f / DM) + EPSF); \
        _Pragma("unroll") for (int k = 0; k < 4; ++k) *(f32x4*)(out + (size_t)(row) * DM + 4 * lane + 256 * k) = Q.v[k] * rstd * g[k]; \
    } } while (0)
    FN_LOAD(0, r0); if (r0 + 1 < r1) FN_LOAD(1, r0 + 1); if (r0 + 2 < r1) FN_LOAD(2, r0 + 2);
#pragma unroll 1
    for (int r = r0; r < r1; r += 4) { FN_STEP(0, r); FN_STEP(1, r + 1); FN_STEP(2, r + 2); FN_STEP(3, r + 3); }
#undef FN_LOAD
#undef FN_STEP
}

#ifndef PROBE_VARIANT
#define PROBE_VARIANT 0
#endif
#ifndef PROBE_PH
#define PROBE_PH -1
#endif
constexpr int NPH = 13;
constexpr unsigned SYNC_AFTER = 0x0FD7u;
__global__ void __launch_bounds__(NTHR, 2) fwd_kernel(Params p, int ph_lo, int ph_hi, int variant) {
    extern __shared__ __attribute__((aligned(16))) unsigned char lds[];
    cg::grid_group grid = cg::this_grid();
    LAS unsigned char* lds3 = (LAS unsigned char*)lds;
    volatile LAS unsigned* bst = (volatile LAS unsigned*)(lds3 + LDS_BYTES - 16);
    if (threadIdx.x < 4) bst[threadIdx.x] = 0u;
    __syncthreads();
    XcdBarrier xbar = xcd_barrier_post((unsigned*)(p.ws + WS_BAR), bst);
    if (ph_hi < 0) grid.sync();
    unsigned char* ws = p.ws;
    const float* MOD = (const float*)(ws + WS_MOD);
    const int xblk = (gridDim.x & 7) ? (int)blockIdx.x : (int)((blockIdx.x & 7) * (gridDim.x >> 3) + (blockIdx.x >> 3));
#ifndef ONLYPH
#define ONLYPH -1
#endif
#define RUN(k) ((ONLYPH < 0 || ONLYPH == (k)) && ph_lo <= (k) && (k) < ph_hi)
#define SEAM(k) do { if (((SYNC_AFTER >> (k)) & 1u) && RUN(k) && (k) + 1 < ph_hi) xcd_barrier(xbar); } while (0)
    if (RUN(0)) phase0(lds, p);
    SEAM(0);
    if (RUN(1)) phase1(lds, p);
    SEAM(1);
    if (RUN(2)) {
        { pg8::Gemm g{(const bf16_t*)(ws + WS_HA), (const bf16_t*)(ws + WS_WIN), MTOK, DIN, DM}; pg8::StaticOrder S; S.init(MTOK, DIN, gridDim.x, blockIdx.x);
          pg8::EpiP E{(bf16_t*)(ws + WS_P), (const float*)(ws + WS_ROPE)};
          pg8::gemm_phase<pg8::EpiP, pg8::StaticOrder>(lds3, g, S, E); }
        if (gridDim.x < 64) { pg8::Gemm g{(const bf16_t*)(ws + WS_HA) + (size_t)MTOK * DM, (const bf16_t*)(ws + WS_WIN) + (size_t)512 * DM, MCTX, 1024, DM}; pg8::StaticOrder S; S.init(MCTX, 1024, gridDim.x, blockIdx.x);
          pg8::EpiKV E{(bf16_t*)(ws + WS_KVC)};
          pg8::gemm_phase<pg8::EpiKV, pg8::StaticOrder>(lds3, g, S, E); }
    }
    SEAM(2);
    const bool split34 = RUN(3) && RUN(4) && gridDim.x >= 128;
    if (RUN(3)) { if (split34) { if (blockIdx.x < 64) ret_state_item(lds, p, blockIdx.x, variant); } else for (int it = blockIdx.x; it < 64; it += gridDim.x) ret_state_item(lds, p, it, variant); }
    SEAM(3);
    if (RUN(4)) {
        constexpr int T_ALL = T_WIN + T_WOUT + T_WGU + T_WDN;
        if (split34) { if (blockIdx.x >= 64) { hy_u_items(lds, p, blockIdx.x - 64, gridDim.x - 64, 4096); transpose_tiles(lds, p, T_WIN + blockIdx.x - 64, gridDim.x - 64, T_ALL); } }
        else { hy_u_items(lds, p, blockIdx.x, gridDim.x, 4096); transpose_tiles(lds, p, T_WIN + blockIdx.x, gridDim.x, T_ALL); }
    }
    SEAM(4);
    if (RUN(6)) ret_out_items(lds, p, blockIdx.x, gridDim.x, 1024);
    if (RUN(5)) { for (int it = blockIdx.x; it < 512; it += gridDim.x) conv_item(lds, p, it); }
    SEAM(6);
    if (RUN(7)) { if (gridDim.x == 256) { for (int kk = 0; kk < 2; ++kk) hy_fin_item(lds, p, (blockIdx.x & 7) * 64 + (blockIdx.x >> 3) + 32 * kk); }
                  else for (int it = blockIdx.x; it < 512; it += gridDim.x) hy_fin_item(lds, p, it); }
    SEAM(7);
    if (RUN(8)) {
        pg8::Gemm g{(const bf16_t*)(ws + WS_MIXIN), (const bf16_t*)(ws + WS_WOUT), MTOK, DM, DM}; pg8::StaticOrder S; S.init(MTOK, DM, gridDim.x, blockIdx.x);
        pg8::EpiGateBf E{(bf16_t*)(ws + WS_MG), MOD + 2 * 1024};
        pg8::gemm_phase<pg8::EpiGateBf, pg8::StaticOrder>(lds3, g, S, E);
    }
    SEAM(8);
    if (RUN(9)) norm_rows(p.in[0], (const bf16_t*)(ws + WS_MG), nullptr, (bf16_t*)(ws + WS_H2), 0, MTOK, p.in[7], MOD, 3, 4, -1, xblk, gridDim.x);
    SEAM(9);
    if (RUN(10)) {
        pg8::Gemm g{(const bf16_t*)(ws + WS_H2), (const bf16_t*)(ws + WS_WGU), MTOK, 2 * DFF, DM}; pg8::StaticOrder S; S.init(MTOK, 2 * DFF, gridDim.x, blockIdx.x);
        pg8::EpiSwiGLU E{(bf16_t*)(ws + WS_ACT)};
        pg8::gemm_phase<pg8::EpiSwiGLU, pg8::StaticOrder>(lds3, g, S, E);
    }
    SEAM(10);
    if (RUN(11)) {
        pg8::Gemm g{(const bf16_t*)(ws + WS_ACT), (const bf16_t*)(ws + WS_WDN), MTOK, DM, DFF}; pg8::StaticOrder S; S.init(MTOK, DM, gridDim.x, blockIdx.x);
        pg8::EpiGateBf E{(bf16_t*)(ws + WS_FG), MOD + 5 * 1024};
        pg8::gemm_phase<pg8::EpiGateBf, pg8::StaticOrder>(lds3, g, S, E);
    }
    SEAM(11);
    if (RUN(12)) final_norm_rows(p.in[0], (const bf16_t*)(ws + WS_MG), (const bf16_t*)(ws + WS_FG), p.out, p.in[26]);
#undef RUN
#undef SEAM
}

extern "C" void kernel_launch(void* const* d_in, const int* in_sizes, int n_in, void* d_out, int out_size, void* d_ws, size_t ws_size, hipStream_t stream) {
    static int grid = 0;
    if (grid == 0) {
        if (n_in != 27 || ws_size < WS_END) { fprintf(stderr, "kernel_launch: unexpected n_in %d or ws_size %zu (< %zu)\n", n_in, ws_size, (size_t)WS_END); grid = -1; return; }
        int dev = 0, cus = 0, per_cu = 0;
        hipGetDevice(&dev);
        hipDeviceGetAttribute(&cus, hipDeviceAttributeMultiprocessorCount, dev);
        if (hipFuncSetAttribute((const void*)fwd_kernel, hipFuncAttributeMaxDynamicSharedMemorySize, LDS_BYTES) != hipSuccess) { fprintf(stderr, "kernel_launch: hipFuncSetAttribute failed\n"); grid = -1; return; }
        hipOccupancyMaxActiveBlocksPerMultiprocessor(&per_cu, (const void*)fwd_kernel, NTHR, LDS_BYTES);
        if (per_cu < 1) { fprintf(stderr, "kernel_launch: occupancy query says %d blocks per CU\n", per_cu); per_cu = 1; }
        (void)hipGetLastError();
        grid = cus * 1;
    }
    if (grid < 0) return;
    Params p{};
    for (int i = 0; i < 27; ++i) p.in[i] = (const float*)d_in[i];
    p.out = (float*)d_out; p.ws = (unsigned char*)d_ws;
#if defined(MULTI_LAUNCH)
    for (int k = 0; k < NPH; ++k) { int lo = k, hi = k + 1; (void)hipMemsetAsync((unsigned char*)d_ws + WS_BAR, 0, XCD_BAR_WORDS * 4, stream); hipLaunchKernelGGL(fwd_kernel, dim3(grid), dim3(NTHR), LDS_BYTES, stream, p, lo, hi, 0); }
#else
    const int nl = PROBE_PH >= 0 ? 2 : 1;
    for (int li = 0; li < nl; ++li) {
        int lo = (PROBE_PH >= 0 && li == 1) ? PROBE_PH : 0, hi = (PROBE_PH >= 0 && li == 0) ? PROBE_PH + 1 : NPH;
        int var = (PROBE_PH >= 0 && li == 0) ? PROBE_VARIANT : 0;
        (void)hipMemsetAsync((unsigned char*)d_ws + WS_BAR, 0, XCD_BAR_WORDS * 4, stream);
        void* args[] = {&p, &lo, &hi, &var};
        hipError_t e = hipLaunchCooperativeKernel((const void*)fwd_kernel, dim3(grid), dim3(NTHR), args, LDS_BYTES, stream);
        if (e != hipSuccess) fprintf(stderr, "cooperative launch failed: %s (grid %d)\n", hipGetErrorString(e), grid);
    }
#endif
}
```
